# Optimizing an MI355X kernel written in HIP

```python
import jax, jax.numpy as jnp
from jax import lax
import numpy as np

D_MODEL = 1024
BATCH = 16
SEQ = 4096
DEPTH = 1
DEC_BATCH = 32
DEC_SEQ = 16
PAST_LEN = 4096

CHUNK = 64
D_MIX = D_MODEL
H_A = 4
W_A = D_MIX // 2
DH_A = W_A // H_A
H_B = 4
W_B = D_MIX - W_A
DH_B = W_B // H_B
CONV_W = 4
N_MEM = 256
N_XHEADS = 4
DH_X = D_MODEL // N_XHEADS
D_FF = 4 * D_MODEL
IN_COLS = 4 * W_A + 2 * H_A + 4 * W_B + 2 * H_B
EPS = 1e-6

kernel_name = 'hybrid_mlstm_gdn_streaming_step'


def rms_norm(x, w):
    xf = x.astype(jnp.float32)
    y = xf * lax.rsqrt(jnp.mean(xf * xf, axis=-1, keepdims=True) + EPS)
    return (y * w.astype(jnp.float32)).astype(x.dtype)


def head_rms_norm(h, w):
    return h * lax.rsqrt(jnp.mean(h * h, axis=-1, keepdims=True) + EPS) * w.astype(jnp.float32)


def l2_normalize(x):
    return x * lax.rsqrt(jnp.sum(x * x, axis=-1, keepdims=True) + EPS)


def split_heads(a, n_heads):
    b, t, _ = a.shape
    return a.reshape(b, t, n_heads, -1).transpose(0, 2, 1, 3)


def merge_heads(a):
    b, h, t, dh = a.shape
    return a.transpose(0, 2, 1, 3).reshape(b, t, h * dh)


def to_chunks(a, chunk):
    b, h, t = a.shape[:3]
    a = a.reshape((b, h, t // chunk, chunk) + a.shape[3:])
    return jnp.moveaxis(a, 2, 0)


def from_chunks(a):
    a = jnp.moveaxis(a, 0, 2)
    b, h, nc, l = a.shape[:4]
    return a.reshape((b, h, nc * l) + a.shape[4:])


def mlstm_chunk_step(carry, inp):
    C0, n0, m0 = carry
    q, k, v, ig, lf = inp
    L = q.shape[-2]
    causal = jnp.tril(jnp.ones((L, L), dtype=bool))
    b = jnp.cumsum(lf, axis=-1)
    d = b[..., :, None] - b[..., None, :] + ig[..., None, :]
    d = jnp.where(causal, d, -jnp.inf)
    inter = b + m0[..., None]
    m = jnp.maximum(inter, jnp.max(d, axis=-1))
    w_intra = jnp.exp(d - m[..., None])
    w_inter = jnp.exp(inter - m)
    s = jnp.einsum('bhtd,bhsd->bhts', q, k) * w_intra
    num = w_inter[..., None] * jnp.einsum('bhtk,bhkv->bhtv', q, C0) + jnp.einsum('bhts,bhsv->bhtv', s, v)
    den = w_inter * jnp.einsum('bhtk,bhk->bht', q, n0) + jnp.sum(s, axis=-1)
    h = num / jnp.maximum(jnp.abs(den), jnp.exp(-m))[..., None]
    b_last = b[..., -1]
    m_last = m[..., -1]
    w_s = jnp.exp(b_last[..., None] - b + ig - m_last[..., None])
    decay0 = jnp.exp(b_last + m0 - m_last)
    C1 = decay0[..., None, None] * C0 + jnp.einsum('bhs,bhsk,bhsv->bhkv', w_s, k, v)
    n1 = decay0[..., None] * n0 + jnp.einsum('bhs,bhsk->bhk', w_s, k)
    return (C1, n1, m_last), h


def gdn_chunk_step(S0, inp):
    q, k, v, g, beta = inp
    L = q.shape[-2]
    incl = jnp.tril(jnp.ones((L, L), dtype=bool))
    strict = jnp.tril(jnp.ones((L, L), dtype=bool), -1)
    G = jnp.cumsum(g, axis=-1)
    decay = jnp.exp(jnp.where(incl, G[..., :, None] - G[..., None, :], -jnp.inf))
    kk = jnp.einsum('bhtd,bhsd->bhts', k, k)
    A = jnp.where(strict, beta[..., None] * decay * kk, 0.0)
    gam = jnp.exp(G)
    rhs = beta[..., None] * (v - gam[..., None] * jnp.einsum('bhtk,bhkv->bhtv', k, S0))
    W = lax.linalg.triangular_solve(A + jnp.eye(L, dtype=A.dtype), rhs,
                                    left_side=True, lower=True, unit_diagonal=True)
    qk = jnp.einsum('bhtd,bhsd->bhts', q, k) * decay
    o = gam[..., None] * jnp.einsum('bhtk,bhkv->bhtv', q, S0) + jnp.einsum('bhts,bhsv->bhtv', qk, W)
    G_last = G[..., -1]
    S1 = jnp.exp(G_last)[..., None, None] * S0 + jnp.einsum('bhs,bhsk,bhsv->bhkv', jnp.exp(G_last[..., None] - G), k, W)
    return S1, o


def causal_short_conv(u, buf, w):
    t = u.shape[1]
    up = jnp.concatenate([buf.astype(u.dtype), u], axis=1)
    y = up[:, 0:t] * w[0]
    for j in range(1, CONV_W):
        y = y + up[:, j:j + t] * w[j]
    return y, up[:, up.shape[1] - (CONV_W - 1):]


def hybrid_mixer(xn, C0, n0, m0, S0, conv_buf, chunk, w_in, mlstm_igate_b, mlstm_fgate_b,
                 mlstm_norm_w, gdn_conv_w, gdn_A_log, gdn_dt_bias, gdn_norm_w, w_out):
    f32 = jnp.float32
    proj = xn @ w_in
    sizes = [W_A, W_A, W_A, W_A, H_A, H_A, 3 * W_B, W_B, H_B, H_B]
    idx = np.cumsum(sizes)[:-1].tolist()
    qa, ka, va, oa, ia, fa, qkvb, zb, ab, bb = jnp.split(proj, idx, axis=-1)
    q = split_heads(qa.astype(f32), H_A)
    k = split_heads(ka.astype(f32), H_A) * (DH_A ** -0.5)
    v = split_heads(va.astype(f32), H_A)
    ig = (ia.astype(f32) + mlstm_igate_b.astype(f32)).transpose(0, 2, 1)
    lf = jax.nn.log_sigmoid(fa.astype(f32) + mlstm_fgate_b.astype(f32)).transpose(0, 2, 1)
    carry0 = (C0.astype(f32), n0.astype(f32), m0.astype(f32))
    (C1, n1, m1), h = lax.scan(mlstm_chunk_step, carry0,
                               (to_chunks(q, chunk), to_chunks(k, chunk), to_chunks(v, chunk),
                                to_chunks(ig, chunk), to_chunks(lf, chunk)))
    h = from_chunks(h)
    h_a = jax.nn.sigmoid(oa.astype(f32)) * merge_heads(head_rms_norm(h, mlstm_norm_w))
    c_out, conv_new = causal_short_conv(qkvb, conv_buf, gdn_conv_w)
    c_out = jax.nn.silu(c_out.astype(f32))
    qb, kb, vb = jnp.split(c_out, 3, axis=-1)
    qb = l2_normalize(split_heads(qb, H_B)) * (DH_B ** -0.5)
    kb = l2_normalize(split_heads(kb, H_B))
    vb = split_heads(vb, H_B)
    g = -jnp.exp(gdn_A_log.astype(f32)) * jax.nn.softplus(ab.astype(f32) + gdn_dt_bias.astype(f32))
    beta = jax.nn.sigmoid(bb.astype(f32))
    g = g.transpose(0, 2, 1)
    beta = beta.transpose(0, 2, 1)
    S1, o = lax.scan(gdn_chunk_step, S0.astype(f32),
                     (to_chunks(qb, chunk), to_chunks(kb, chunk), to_chunks(vb, chunk),
                      to_chunks(g, chunk), to_chunks(beta, chunk)))
    o = from_chunks(o)
    h_b = merge_heads(head_rms_norm(o, gdn_norm_w)) * jax.nn.silu(zb.astype(f32))
    y = jnp.concatenate([h_a, h_b], axis=-1).astype(xn.dtype) @ w_out
    return y, C1, n1, m1, S1, conv_new


def memory_kv(mem, norm_mem_w, wk, wv):
    b = mem.shape[0]
    mn = rms_norm(mem, norm_mem_w)
    mk = (mn @ wk).reshape(b, N_MEM, N_XHEADS, DH_X)
    mv = (mn @ wv).reshape(b, N_MEM, N_XHEADS, DH_X)
    return mk, mv


def memory_cross_attention(xn, mem_k, mem_v, wq, wo):
    b, t, _ = xn.shape
    q = (xn @ wq).reshape(b, t, N_XHEADS, DH_X)
    s = jnp.einsum('bthd,bnhd->bhtn', q, mem_k.astype(q.dtype)).astype(jnp.float32) * (DH_X ** -0.5)
    p = jax.nn.softmax(s, axis=-1).astype(xn.dtype)
    o = jnp.einsum('bhtn,bnhd->bthd', p, mem_v.astype(xn.dtype)).reshape(b, t, D_MODEL)
    return o @ wo


def squared_relu_mlp(xn, w1, w2):
    hdn = jax.nn.relu(xn @ w1)
    return (hdn * hdn) @ w2


def trunk_layer(x, mem_k, mem_v, C0, n0, m0, S0, conv_buf, chunk, norm_mix_w, w_in, mlstm_igate_b,
                mlstm_fgate_b, mlstm_norm_w, gdn_conv_w, gdn_A_log, gdn_dt_bias, gdn_norm_w, w_out,
                norm_x_w, wq_x, wo_x, norm_ffn_w, w_ff1, w_ff2):
    y, C1, n1, m1, S1, conv_new = hybrid_mixer(
        rms_norm(x, norm_mix_w), C0, n0, m0, S0, conv_buf, chunk, w_in, mlstm_igate_b, mlstm_fgate_b,
        mlstm_norm_w, gdn_conv_w, gdn_A_log, gdn_dt_bias, gdn_norm_w, w_out)
    x = x + y
    x = x + memory_cross_attention(rms_norm(x, norm_x_w), mem_k, mem_v, wq_x, wo_x)
    x = x + squared_relu_mlp(rms_norm(x, norm_ffn_w), w_ff1, w_ff2)
    return x, C1.astype(x.dtype), n1.astype(x.dtype), m1.astype(x.dtype), S1.astype(x.dtype), conv_new


def setup_inputs(seed: int = 0) -> dict:
    key = jax.random.key(seed)
    keys = list(jax.random.split(key, 48))
    f32 = jnp.float32

    def nrm(shape, scale):
        return jax.random.normal(keys.pop(), shape, f32) * scale

    def gain(shape):
        return 1.0 + 0.1 * jax.random.normal(keys.pop(), shape, f32)

    dt = jnp.exp(jax.random.uniform(keys.pop(), (DEPTH, H_B), f32, np.log(1e-3), np.log(1e-1)))
    inputs = {
        'x_prompt': nrm((BATCH, SEQ, D_MODEL), 1.0),
        'x_sample': nrm((DEC_BATCH, DEC_SEQ, D_MODEL), 1.0),
        'state_mlstm_C': nrm((DEPTH, DEC_BATCH, H_A, DH_A, DH_A), DH_A ** -0.5),
        'state_mlstm_n': nrm((DEPTH, DEC_BATCH, H_A, DH_A), DH_A ** -0.5),
        'state_mlstm_m': nrm((DEPTH, DEC_BATCH, H_A), 1.0),
        'state_gdn_S': nrm((DEPTH, DEC_BATCH, H_B, DH_B, DH_B), DH_B ** -0.5),
        'state_gdn_conv': nrm((DEPTH, DEC_BATCH, CONV_W - 1, 3 * W_B), 1.0),
        'cache_mem_k': nrm((DEPTH, DEC_BATCH, N_MEM, N_XHEADS, DH_X), 1.0),
        'cache_mem_v': nrm((DEPTH, DEC_BATCH, N_MEM, N_XHEADS, DH_X), 1.0),
        'mem_prompt': nrm((BATCH, N_MEM, D_MODEL), 1.0),
        'norm_mix_w': gain((DEPTH, D_MODEL)),
        'w_in': nrm((DEPTH, D_MODEL, IN_COLS), D_MODEL ** -0.5),
        'mlstm_igate_b': nrm((DEPTH, H_A), 0.1),
        'mlstm_fgate_b': jnp.linspace(3.0, 6.0, H_A, dtype=f32)[None, :] + nrm((DEPTH, H_A), 0.1),
        'mlstm_norm_w': gain((DEPTH, DH_A)),
        'gdn_conv_w': nrm((DEPTH, CONV_W, 3 * W_B), CONV_W ** -0.5),
        'gdn_A_log': jnp.log(jax.random.uniform(keys.pop(), (DEPTH, H_B), f32, 1.0, 16.0)),
        'gdn_dt_bias': dt + jnp.log(-jnp.expm1(-dt)),
        'gdn_norm_w': gain((DEPTH, DH_B)),
        'w_out': nrm((DEPTH, D_MIX, D_MODEL), D_MIX ** -0.5),
        'norm_x_w': gain((DEPTH, D_MODEL)),
        'norm_mem_w': gain((DEPTH, D_MODEL)),
        'wq_x': nrm((DEPTH, D_MODEL, D_MODEL), D_MODEL ** -0.5),
        'wk_x': nrm((DEPTH, D_MODEL, D_MODEL), D_MODEL ** -0.5),
        'wv_x': nrm((DEPTH, D_MODEL, D_MODEL), D_MODEL ** -0.5),
        'wo_x': nrm((DEPTH, D_MODEL, D_MODEL), D_MODEL ** -0.5),
        'norm_ffn_w': gain((DEPTH, D_MODEL)),
        'w_ff1': nrm((DEPTH, D_MODEL, D_FF), D_MODEL ** -0.5),
        'w_ff2': nrm((DEPTH, D_FF, D_MODEL), D_FF ** -0.5),
        'norm_final_w': gain((D_MODEL,)),
    }
    return inputs


def reference(x_prompt, x_sample, state_mlstm_C, state_mlstm_n, state_mlstm_m, state_gdn_S,
              state_gdn_conv, cache_mem_k, cache_mem_v, mem_prompt, norm_mix_w, w_in, mlstm_igate_b,
              mlstm_fgate_b, mlstm_norm_w, gdn_conv_w, gdn_A_log, gdn_dt_bias, gdn_norm_w, w_out,
              norm_x_w, norm_mem_w, wq_x, wk_x, wv_x, wo_x, norm_ffn_w, w_ff1, w_ff2, norm_final_w):
    f32 = jnp.float32
    bp = x_prompt.shape[0]
    sample_chunk = x_sample.shape[1]
    hp, hs = x_prompt, x_sample
    pC, pn, pm, pS, pconv, pmk, pmv = [], [], [], [], [], [], []
    sC, sn, sm, sS, sconv = [], [], [], [], []
    for l in range(DEPTH):
        mk_p, mv_p = memory_kv(mem_prompt, norm_mem_w[l], wk_x[l], wv_x[l])
        hp, C1, n1, m1, S1, cv1 = trunk_layer(
            hp, mk_p, mv_p,
            jnp.zeros((bp, H_A, DH_A, DH_A), f32), jnp.zeros((bp, H_A, DH_A), f32),
            jnp.zeros((bp, H_A), f32), jnp.zeros((bp, H_B, DH_B, DH_B), f32),
            jnp.zeros((bp, CONV_W - 1, 3 * W_B), hp.dtype), CHUNK,
            norm_mix_w[l], w_in[l], mlstm_igate_b[l], mlstm_fgate_b[l], mlstm_norm_w[l], gdn_conv_w[l],
            gdn_A_log[l], gdn_dt_bias[l], gdn_norm_w[l], w_out[l], norm_x_w[l], wq_x[l], wo_x[l],
            norm_ffn_w[l], w_ff1[l], w_ff2[l])
        pC.append(C1); pn.append(n1); pm.append(m1); pS.append(S1); pconv.append(cv1)
        pmk.append(mk_p); pmv.append(mv_p)
        hs, C2, n2, m2, S2, cv2 = trunk_layer(
            hs, cache_mem_k[l], cache_mem_v[l], state_mlstm_C[l], state_mlstm_n[l], state_mlstm_m[l],
            state_gdn_S[l], state_gdn_conv[l], sample_chunk,
            norm_mix_w[l], w_in[l], mlstm_igate_b[l], mlstm_fgate_b[l], mlstm_norm_w[l], gdn_conv_w[l],
            gdn_A_log[l], gdn_dt_bias[l], gdn_norm_w[l], w_out[l], norm_x_w[l], wq_x[l], wo_x[l],
            norm_ffn_w[l], w_ff1[l], w_ff2[l])
        sC.append(C2); sn.append(n2); sm.append(m2); sS.append(S2); sconv.append(cv2)
    y_prompt = rms_norm(hp, norm_final_w)
    y_sample = rms_norm(hs, norm_final_w)
    return (y_prompt, y_sample,
            jnp.stack(pC), jnp.stack(pn), jnp.stack(pm), jnp.stack(pS), jnp.stack(pconv),
            jnp.stack(pmk), jnp.stack(pmv),
            jnp.stack(sC), jnp.stack(sn), jnp.stack(sm), jnp.stack(sS), jnp.stack(sconv))
```

```cpp
#include <hip/hip_cooperative_groups.h>
#include <cstdio>
#include <cstdint>
#include <hip/hip_runtime.h>
namespace pg8 {
#define PG8_LAS __attribute__((address_space(3)))
typedef unsigned short bf16_t;
typedef short bf16x8 __attribute__((ext_vector_type(8)));
typedef float f32x4 __attribute__((ext_vector_type(4)));
typedef unsigned u32x4 __attribute__((ext_vector_type(4)));
constexpr int BM = 256, BK = 64, HALF = 128, HTB = HALF * BK * 2  , STAGE_BYTES = 8 * HTB, NXCD = 8, WGM = 8;

__host__ __device__ __forceinline__ int lds_byte(int r, int c) { const int st = (r >> 4) * 2 + (c >> 5), rr = r & 15, cc = c & 31, ob = rr * 64 + cc * 2; return st * 1024 + (ob ^ (((ob >> 9) & 1) << 5)); }
__host__ __device__ __forceinline__ void stage_rc(int b, int& R, int& C) { const int st = b / 1024, sb = b % 1024, swz = sb ^ (((sb >> 9) & 1) << 5); R = (st >> 1) * 16 + swz / 64; C = (st & 1) * 32 + (swz % 64) / 2; }
__host__ __device__ __forceinline__ int perm32(int rho) { const int n = rho >> 4, i = rho & 15; return 8 * (i >> 2) + 4 * n + (i & 3); }

struct Unit { int pm, pn; };
struct Gemm { const bf16_t* A; const bf16_t* Bt; int M, N, K; };

struct StaticOrder {
    int nM, nN, nwg, G, c;
    __host__ __device__ void init(int M, int N, int G_, int c_) { nM = M / BM; nN = N / BM; nwg = nM * nN; G = G_; c = c_; }
    __host__ __device__ bool next(int i, Unit& u) const {
        const long L = (long)i * G + c; if (L >= nwg) return false;
        int wgid = (int)L; { const int q = nwg / NXCD, r = nwg % NXCD, xcd = wgid % NXCD, off = wgid / NXCD; wgid = (xcd < r ? xcd * (q + 1) : r * (q + 1) + (xcd - r) * q) + off; }
        const int nig = WGM * nN, gid = wgid / nig, fm = gid * WGM, gsz = (nM - fm) < WGM ? (nM - fm) : WGM;
        u.pm = fm + ((wgid % nig) % gsz); u.pn = (wgid % nig) / gsz; return true;
    }
    __device__ __forceinline__ void a_ready(const Unit&) const {}
    __device__ __forceinline__ void done(const Unit&) const {}
};
__device__ __forceinline__ unsigned cvt_pk_bf16(float lo, float hi) { unsigned r; asm volatile("v_cvt_pk_bf16_f32 %0, %1, %2" : "=v"(r) : "v"(lo), "v"(hi)); return r; }

template <class Epi, class Sched, bool STAMP = false>
__device__ __forceinline__ void gemm_phase(PG8_LAS unsigned char* lds, const Gemm g, const Sched& S, const Epi& E, unsigned long long* stamps) {
    int tid_ = threadIdx.x; asm volatile("" : "+v"(tid_)); const int tid = tid_, wid = __builtin_amdgcn_readfirstlane(tid >> 6), lane = tid & 63, wr = wid >> 2, wc = wid & 3, fr = lane & 15, fq = lane >> 4;
    const int K = g.K, nt = K / BK;
    int ts_lo = 0, ts_hi = 0, nts = 0; const unsigned long long rt_entry = STAMP ? (unsigned long long)wall_clock64() : 0ull;
#define PG8_STAMP() do { if (STAMP && wid == 0 && nts < 64) { const unsigned long long _c = (unsigned long long)clock64(); \
        ts_lo = (lane == nts) ? (int)(unsigned)_c : ts_lo; ts_hi = (lane == nts) ? (int)(unsigned)(_c >> 32) : ts_hi; ++nts; } } while (0)
    PG8_STAMP();
    unsigned voffA[2], voffB[2];
#pragma unroll
    for (int i = 0; i < 2; ++i) { int R, C; stage_rc(tid * 16 + i * 8192, R, C); const int Rb = Epi::PERM ? ((R & ~31) + perm32(R & 31)) : R;
        voffA[i] = (unsigned)(R * K + C) * 2u; voffB[i] = (unsigned)(Rb * K + C) * 2u; }
    const size_t kstep = (size_t)(BK * 2);
    const size_t hstep = (size_t)HALF * K * 2;
    const size_t tstep = 2 * hstep;
    const unsigned ldsw = (unsigned)wid * 1024u;
    const int aoff = lds_byte(wr * 64 + fr, fq * 8), boff = lds_byte(wc * 32 + fr, fq * 8);
#define PG8_SA(b, h) (((b) * 2 + (h)) * HTB)
#define PG8_SB(b, h) ((4 + (b) * 2 + (h)) * HTB)
#define PG8_STAGE(bufoff, gbase, voff) do { _Pragma("unroll") for (int _i = 0; _i < 2; ++_i) \
        __builtin_amdgcn_global_load_lds((const unsigned*)((const char*)(gbase) + (voff)[_i]), (PG8_LAS unsigned*)(lds + (bufoff) + ldsw + _i * 8192), 16, 0, 0); } while (0)
#define PG8_LDA(dst, b, h) do { _Pragma("unroll") for (int m = 0; m < 4; ++m) _Pragma("unroll") for (int k = 0; k < 2; ++k) dst[m][k] = *(const PG8_LAS bf16x8*)(lds + PG8_SA(b, h) + aoff + m * 2048 + k * 1024); } while (0)
#define PG8_LDB(dst, b, h) do { _Pragma("unroll") for (int n = 0; n < 2; ++n) _Pragma("unroll") for (int k = 0; k < 2; ++k) dst[n][k] = *(const PG8_LAS bf16x8*)(lds + PG8_SB(b, h) + boff + n * 2048 + k * 1024); } while (0)
#define PG8_MMA(ai, bj, At, Bt) do { __builtin_amdgcn_s_setprio(1); _Pragma("unroll") for (int m = 0; m < 4; ++m) _Pragma("unroll") for (int n = 0; n < 2; ++n) _Pragma("unroll") for (int k = 0; k < 2; ++k) \
        acc[ai][bj][m][n] = __builtin_amdgcn_mfma_f32_16x16x32_bf16(Bt[n][k], At[m][k], acc[ai][bj][m][n], 0, 0, 0); __builtin_amdgcn_s_setprio(0); } while (0)
#define PG8_WAIT_V(n) asm volatile("s_waitcnt vmcnt(" #n ")" ::: "memory")
#define PG8_WAIT_L(n) asm volatile("s_waitcnt lgkmcnt(" #n ")" ::: "memory")
#define PG8_BAR __builtin_amdgcn_s_barrier()
#define PG8_SCHED __builtin_amdgcn_sched_barrier(0)
    Unit cur, nxt; int ui = 0;
    if (!S.next(0, cur)) return;
    f32x4 acc[2][2][4][2];
#pragma unroll
    for (int a = 0; a < 2; ++a)
#pragma unroll
        for (int b = 0; b < 2; ++b)
#pragma unroll
            for (int m = 0; m < 4; ++m)
#pragma unroll
                for (int n = 0; n < 2; ++n) acc[a][b][m][n] = (f32x4){0.f, 0.f, 0.f, 0.f};
    bf16x8 At[4][2], B0[2][2], B1[2][2];
    const char* cA = (const char*)g.A + (size_t)cur.pm * tstep; const char* cB = (const char*)g.Bt + (size_t)cur.pn * tstep;
    S.a_ready(cur);
    PG8_STAGE(PG8_SB(0, 0), cB, voffB); PG8_STAGE(PG8_SA(0, 0), cA, voffA); PG8_STAGE(PG8_SB(0, 1), cB + hstep, voffB); PG8_STAGE(PG8_SA(0, 1), cA + hstep, voffA);
    if (wr == 1) PG8_BAR;
    PG8_WAIT_V(4); PG8_BAR;
    PG8_STAGE(PG8_SB(1, 0), cB + kstep, voffB); PG8_STAGE(PG8_SA(1, 0), cA + kstep, voffA); PG8_STAGE(PG8_SB(1, 1), cB + hstep + kstep, voffB);
    PG8_WAIT_V(6); PG8_BAR;
    PG8_STAMP();
    for (;;) {
        const bool has_next = S.next(ui + 1, nxt);
        const char* nA = has_next ? (const char*)g.A + (size_t)nxt.pm * tstep : cA; const char* nB = has_next ? (const char*)g.Bt + (size_t)nxt.pn * tstep : cB;
        for (int t = 0; t < nt; t += 2) {
            const bool last = (t == nt - 2);
            const char* a1 = cA + (size_t)(t + 1) * kstep;
            const char* a2 = last ? nA : cA + (size_t)(t + 2) * kstep; const char* b2 = last ? nB : cB + (size_t)(t + 2) * kstep;
            const char* a3 = a2 + kstep; const char* b3 = b2 + kstep;
            if (last && has_next) S.a_ready(nxt);
            PG8_LDB(B0, 0, 0); PG8_SCHED; PG8_LDA(At, 0, 0); PG8_STAGE(PG8_SA(1, 1), a1 + hstep, voffA);
            PG8_WAIT_L(8); PG8_BAR; PG8_WAIT_L(0); PG8_MMA(0, 0, At, B0); PG8_BAR; PG8_SCHED;
            PG8_LDB(B1, 0, 1); PG8_STAGE(PG8_SB(0, 0), b2, voffB);
            PG8_BAR; PG8_WAIT_L(0); PG8_MMA(0, 1, At, B1); PG8_BAR;
            PG8_LDA(At, 0, 1); PG8_STAGE(PG8_SA(0, 0), a2, voffA);
            PG8_BAR; PG8_WAIT_L(0); PG8_MMA(1, 0, At, B0); PG8_BAR; PG8_SCHED;
            PG8_STAGE(PG8_SB(0, 1), b2 + hstep, voffB);
            PG8_WAIT_V(6); PG8_BAR; PG8_MMA(1, 1, At, B1); PG8_BAR;
            PG8_LDB(B0, 1, 0); PG8_SCHED; PG8_LDA(At, 1, 0); PG8_STAGE(PG8_SA(0, 1), a2 + hstep, voffA);
            PG8_WAIT_L(8); PG8_BAR; PG8_WAIT_L(0); PG8_MMA(0, 0, At, B0); PG8_BAR; PG8_SCHED;
            PG8_LDB(B1, 1, 1); PG8_STAGE(PG8_SB(1, 0), b3, voffB);
            PG8_BAR; PG8_WAIT_L(0); PG8_MMA(0, 1, At, B1); PG8_BAR;
            PG8_LDA(At, 1, 1); PG8_STAGE(PG8_SA(1, 0), a3, voffA);
            PG8_BAR; PG8_WAIT_L(0); PG8_MMA(1, 0, At, B0); PG8_BAR; PG8_SCHED;
            PG8_STAGE(PG8_SB(1, 1), b3 + hstep, voffB);
            PG8_WAIT_V(6); PG8_BAR; PG8_MMA(1, 1, At, B1); PG8_BAR;
        }
        PG8_STAMP();
        if constexpr (!Epi::AFTER_DRAIN) { E(acc, cur, wr, wc, fr, fq); S.done(cur); }
        PG8_STAMP();
        if (!has_next) break;
#pragma unroll
        for (int a = 0; a < 2; ++a)
#pragma unroll
            for (int b = 0; b < 2; ++b)
#pragma unroll
                for (int m = 0; m < 4; ++m)
#pragma unroll
                    for (int n = 0; n < 2; ++n) acc[a][b][m][n] = (f32x4){0.f, 0.f, 0.f, 0.f};
        cur = nxt; cA = nA; cB = nB; ++ui;
    }
    PG8_WAIT_V(0);
    if (wr == 0) PG8_BAR;
    PG8_BAR;
    if constexpr (Epi::AFTER_DRAIN) { E.fused(acc, cur, wr, wc, fr, fq, lds, wid, lane); S.done(cur); }
    PG8_STAMP();
    if (STAMP && wid == 0) { stamps[lane] = lane < nts ? (((unsigned long long)(unsigned)ts_hi << 32) | (unsigned)ts_lo) : 0ull;
        if (lane == 62) stamps[62] = rt_entry; if (lane == 63) stamps[63] = (unsigned long long)wall_clock64(); }
#undef PG8_STAMP
#undef PG8_SA
#undef PG8_SB
#undef PG8_STAGE
#undef PG8_LDA
#undef PG8_LDB
#undef PG8_MMA
#undef PG8_WAIT_V
#undef PG8_WAIT_L
#undef PG8_BAR
#undef PG8_SCHED
}
}

#ifndef STOP_AFTER
#define STOP_AFTER 99
#endif
namespace cg = cooperative_groups;
using pg8::bf16_t; using pg8::bf16x8; using pg8::f32x4; using pg8::u32x4; using pg8::Unit;
#define LAS __attribute__((address_space(3)))
#define DI __device__ __forceinline__
typedef unsigned u32x2 __attribute__((ext_vector_type(2)));

constexpr int DM = 1024, NP = 65536, NS = 512, NTOK = NP + NS, SEQ = 4096, NB_P = 16, NB_S = 32, TS = 16;
constexpr int INC = 4112, NMAIN = 4096, DFF = 4096, NMEM = 256;
constexpr float EPS = 1e-6f;
constexpr float SCALE_H = 0.08838834764831845f;
constexpr size_t O_Y = 0, O_PC = (size_t)NTOK * DM, O_PN = O_PC + 16 * 4 * 128 * 128, O_PM = O_PN + 16 * 4 * 128, O_PS = O_PM + 64,
                 O_PCONV = O_PS + 16 * 4 * 128 * 128, O_PMK = O_PCONV + 16 * 3 * 1536, O_PMV = O_PMK + (size_t)16 * 256 * 1024,
                 O_SC = O_PMV + (size_t)16 * 256 * 1024, O_SN = O_SC + 32 * 4 * 128 * 128, O_SM = O_SN + 32 * 4 * 128, O_SS = O_SM + 128,
                 O_SCONV = O_SS + 32 * 4 * 128 * 128, O_END = O_SCONV + 32 * 3 * 1536;
constexpr size_t W_IN = 0, W_OUT = W_IN + (size_t)NMAIN * DM * 2, W_Q = W_OUT + (size_t)DM * DM * 2, W_K = W_Q + (size_t)DM * DM * 2, W_V = W_K + (size_t)DM * DM * 2,
                 W_O = W_V + (size_t)DM * DM * 2, W_1 = W_O + (size_t)DM * DM * 2, W_2 = W_1 + (size_t)DFF * DM * 2, W_XN = W_2 + (size_t)DFF * DM * 2,
                 W_PROJ = W_XN + (size_t)NTOK * DM * 2, W_HCAT = W_PROJ + (size_t)NTOK * NMAIN * 2, W_GATES = W_HCAT + (size_t)NTOK * DM * 2,
                 W_MN = W_GATES + (size_t)NTOK * 16 * 4, W_KBP = W_MN + (size_t)4096 * DM * 2, W_VTP = W_KBP + (size_t)4096 * DM * 2,
                 W_KBS = W_VTP + (size_t)4096 * DM * 2, W_VTS = W_KBS + (size_t)8192 * DM * 2, W_TAB = W_VTS + (size_t)8192 * DM * 2, W_END = W_TAB + 4096;
constexpr int LDS_BYTES = 156 * 1024;

struct Params {
    const float *x_prompt, *x_sample, *st_C, *st_n, *st_m, *st_S, *st_conv, *cache_k, *cache_v, *mem_prompt;
    const float *norm_mix_w, *w_in, *ig_b, *fg_b, *mlstm_norm_w, *conv_w, *A_log, *dt_bias, *gdn_norm_w, *w_out;
    const float *norm_x_w, *norm_mem_w, *wq, *wk, *wv, *wo, *norm_ffn_w, *w1, *w2, *norm_final_w;
    float* out; unsigned char* ws;
};

DI unsigned pk2(float lo, float hi) { unsigned r; asm("v_cvt_pk_bf16_f32 %0, %1, %2" : "=v"(r) : "v"(lo), "v"(hi)); return r; }
DI unsigned pk2a(float lo, float hi) { unsigned r; asm volatile("v_cvt_pk_bf16_f32 %0, %1, %2" : "=v"(r) : "v"(lo), "v"(hi)); return r; }
DI bf16_t f2bf(float f) { return __builtin_bit_cast(unsigned short, (__bf16)f); }
DI float bf2f(bf16_t b) { return __uint_as_float(((unsigned)b) << 16); }
DI float bflo(unsigned u) { return __uint_as_float(u << 16); }
DI float bfhi(unsigned u) { return __uint_as_float(u & 0xffff0000u); }
DI int get_tid() { int t = threadIdx.x; asm volatile("" : "+v"(t)); return t; }
DI float wave_sum(float v) {
#pragma unroll
    for (int o = 1; o < 64; o <<= 1) v += __shfl_xor(v, o);
    return v;
}
DI float sigmoidf_(float x) { return 1.f / (1.f + __expf(-x)); }
#define LDS_WAIT() asm volatile("s_waitcnt lgkmcnt(0)" ::: "memory")

template <int K> DI f32x4 mm16(const LAS bf16_t* A, int lda, const LAS bf16_t* B, int ldb, f32x4 acc, int lane) {
    const LAS bf16_t* pa = A + (lane & 15) * lda + (lane >> 4) * 8;
    const LAS bf16_t* pb = B + (lane & 15) * ldb + (lane >> 4) * 8;
#pragma unroll
    for (int k = 0; k < K; k += 32) {
        const bf16x8 a = *(const LAS bf16x8*)(pa + k), b = *(const LAS bf16x8*)(pb + k);
        acc = __builtin_amdgcn_mfma_f32_16x16x32_bf16(a, b, acc, 0, 0, 0);
    }
    return acc;
}

template <int ACT> struct EpiBf16 {
    static constexpr bool PERM = true, AFTER_DRAIN = false;
    bf16_t* O; int ldc;
    DI void operator()(const f32x4 (&acc)[2][2][4][2], const Unit& u, int wr, int wc, int fr, int fq) const {
        const int row0 = u.pm * 256 + wr * 64 + fr, col0 = u.pn * 256 + wc * 32 + 8 * fq;
#pragma unroll
        for (int ai = 0; ai < 2; ++ai)
#pragma unroll
            for (int m = 0; m < 4; ++m) { bf16_t* rowp = O + (size_t)(row0 + ai * 128 + m * 16) * ldc + col0;
#pragma unroll
                for (int bj = 0; bj < 2; ++bj) { f32x4 v0 = acc[ai][bj][m][0], v1 = acc[ai][bj][m][1];
                    if (ACT == 1) {
#pragma unroll
                        for (int e = 0; e < 4; ++e) { float a = fmaxf(v0[e], 0.f), b = fmaxf(v1[e], 0.f); v0[e] = a * a; v1[e] = b * b; } }
                    u32x4 o; o.x = pk2a(v0[0], v0[1]); o.y = pk2a(v0[2], v0[3]); o.z = pk2a(v1[0], v1[1]); o.w = pk2a(v1[2], v1[3]);
                    *(u32x4*)(rowp + bj * 128) = o; } }
    }
};
struct EpiF32 {
    static constexpr bool PERM = false, AFTER_DRAIN = false;
    float* C; int ldc;
    DI void operator()(const f32x4 (&acc)[2][2][4][2], const Unit& u, int wr, int wc, int fr, int fq) const {
        const int row0 = u.pm * 256 + wr * 64 + fr, col0 = u.pn * 256 + wc * 32 + 4 * fq;
#pragma unroll
        for (int ai = 0; ai < 2; ++ai)
#pragma unroll
            for (int m = 0; m < 4; ++m) { float* rowp = C + (size_t)(row0 + ai * 128 + m * 16) * ldc + col0;
#pragma unroll
                for (int bj = 0; bj < 2; ++bj)
#pragma unroll
                    for (int n = 0; n < 2; ++n) *(f32x4*)(rowp + bj * 128 + n * 16) = acc[ai][bj][m][n]; }
    }
};
struct EpiRes {
    static constexpr bool PERM = false, AFTER_DRAIN = false;
    float* out; const float* resP; const float* resS;
    DI void operator()(const f32x4 (&acc)[2][2][4][2], const Unit& u, int wr, int wc, int fr, int fq) const {
        const int row0 = u.pm * 256 + wr * 64 + fr, col0 = u.pn * 256 + wc * 32 + 4 * fq;
        const float* rbase = (u.pm < NP / 256) ? resP + (size_t)row0 * DM : resS + (size_t)(row0 - NP) * DM;
#pragma unroll
        for (int ai = 0; ai < 2; ++ai)
#pragma unroll
            for (int m = 0; m < 4; ++m) { const size_t ro = (size_t)(ai * 128 + m * 16) * DM + col0; const float* rp = rbase + ro; float* op = out + (size_t)row0 * DM + ro;
#pragma unroll
                for (int bj = 0; bj < 2; ++bj)
#pragma unroll
                    for (int n = 0; n < 2; ++n) *(f32x4*)(op + bj * 128 + n * 16) = *(const f32x4*)(rp + bj * 128 + n * 16) + acc[ai][bj][m][n]; }
    }
};
template <class Epi> DI void run_gemm(LAS unsigned char* lds, const bf16_t* A, const bf16_t* Bt, int M, int N, int K, const Epi& E, int cshift) {
    pg8::Gemm g; g.A = A; g.Bt = Bt; g.M = M; g.N = N; g.K = K;
    pg8::StaticOrder S; S.init(M, N, (int)gridDim.x, (int)((blockIdx.x + gridDim.x - cshift) % gridDim.x));
    pg8::gemm_phase<Epi, pg8::StaticOrder, false>(lds, g, S, E, nullptr);
    __syncthreads();
}

DI void transpose_item(const float* src, int ld, bf16_t* dst, int ldd, LAS float* scr, int k0, int n0, int lane) {
#pragma unroll 8
    for (int i = 0; i < 32; ++i) { const int kk = 2 * i + (lane >> 5); scr[kk * 33 + (lane & 31)] = src[(size_t)(k0 + kk) * ld + n0 + (lane & 31)]; }
    LDS_WAIT();
    const int c = lane & 7;
#pragma unroll
    for (int j = 0; j < 4; ++j) { const int n = (lane >> 3) + 8 * j; const LAS float* s = scr + (8 * c) * 33 + n;
        u32x4 o; o.x = pk2(s[0 * 33], s[1 * 33]); o.y = pk2(s[2 * 33], s[3 * 33]); o.z = pk2(s[4 * 33], s[5 * 33]); o.w = pk2(s[6 * 33], s[7 * 33]);
        *(u32x4*)(dst + (size_t)(n0 + n) * ldd + k0 + 8 * c) = o; }
    LDS_WAIT();
}
template <bool GATES> DI void norm_row(const float* xrow, const float* w, bf16_t* orow, float* grow, const LAS float* wg, int lane) {
    f32x4 v[4]; float s = 0.f;
#pragma unroll
    for (int j = 0; j < 4; ++j) { v[j] = *(const f32x4*)(xrow + 4 * lane + 256 * j); s += (v[j].x * v[j].x + v[j].y * v[j].y) + (v[j].z * v[j].z + v[j].w * v[j].w); }
    const float rstd = rsqrtf(wave_sum(s) * (1.f / DM) + EPS);
#pragma unroll
    for (int j = 0; j < 4; ++j) { const f32x4 wv = *(const f32x4*)(w + 4 * lane + 256 * j); v[j] = v[j] * rstd * wv;
        u32x2 o; o.x = pk2(v[j].x, v[j].y); o.y = pk2(v[j].z, v[j].w); *(u32x2*)(orow + 4 * lane + 256 * j) = o; }
    if (GATES) {
        float g[16];
#pragma unroll
        for (int gi = 0; gi < 16; ++gi) { float a = 0.f;
#pragma unroll
            for (int j = 0; j < 4; ++j) { const f32x4 ww = *(const LAS f32x4*)(wg + gi * 1024 + 4 * lane + 256 * j); a += (v[j].x * ww.x + v[j].y * ww.y) + (v[j].z * ww.z + v[j].w * ww.w); }
            g[gi] = a; }
#pragma unroll
        for (int i = 0; i < 8; ++i) { const bool up = lane & 1; const float send = up ? g[i] : g[i + 8], keep = up ? g[i + 8] : g[i]; g[i] = keep + __shfl_xor(send, 1); }
#pragma unroll
        for (int i = 0; i < 4; ++i) { const bool up = lane & 2; const float send = up ? g[i] : g[i + 4], keep = up ? g[i + 4] : g[i]; g[i] = keep + __shfl_xor(send, 2); }
#pragma unroll
        for (int i = 0; i < 2; ++i) { const bool up = lane & 4; const float send = up ? g[i] : g[i + 2], keep = up ? g[i + 2] : g[i]; g[i] = keep + __shfl_xor(send, 4); }
        { const bool up = lane & 8; const float send = up ? g[0] : g[1], keep = up ? g[1] : g[0]; g[0] = keep + __shfl_xor(send, 8); }
        g[0] += __shfl_xor(g[0], 16); g[0] += __shfl_xor(g[0], 32);
        const int idx = ((lane & 1) << 3) | ((lane & 2) << 1) | ((lane & 4) >> 1) | ((lane & 8) >> 3);
        if (lane < 16) grow[idx] = g[0];
    }
}
DI void transpose_matrix(const float* src, int ld, int K, int N, bf16_t* dst, LAS float* scr, int& cursor, int gw, int NGW, int lane) {
    const int nkb = K / 64, nnb = N / 32, items = nkb * nnb;
    int first = (gw - cursor % NGW + NGW) % NGW;
    for (int it = first; it < items; it += NGW) { const int kb = it / nnb, nb = it % nnb; transpose_item(src, ld, dst, K, scr, kb * 64, nb * 32, lane); }
    cursor += items;
}

DI void phase0(const Params& P, LAS unsigned char* lds) {
    const int tid = get_tid(), lane = tid & 63, wave = tid >> 6, gw = blockIdx.x * 8 + wave, NGW = gridDim.x * 8;
    LAS float* wg = (LAS float*)lds;
    LAS float* scr = (LAS float*)(lds + 65536 + wave * 8448);
    for (int i = tid; i < 16 * 1024; i += 512) { const int g = i >> 10, k = i & 1023; const int col = g < 8 ? 2048 + g : 4104 + (g - 8); wg[i] = P.w_in[(size_t)k * INC + col]; }
    __syncthreads();
    bf16_t* WS = (bf16_t*)P.ws;
    { bf16_t* XN = (bf16_t*)(P.ws + W_XN); float* GT = (float*)(P.ws + W_GATES);
      for (int r = gw; r < NTOK; r += NGW) { const float* xr = r < NP ? P.x_prompt + (size_t)r * DM : P.x_sample + (size_t)(r - NP) * DM;
          norm_row<true>(xr, P.norm_mix_w, XN + (size_t)r * DM, GT + (size_t)r * 16, wg, lane); }
      bf16_t* MN = (bf16_t*)(P.ws + W_MN);
      for (int r = gw; r < 4096; r += NGW) norm_row<false>(P.mem_prompt + (size_t)r * DM, P.norm_mem_w, MN + (size_t)r * DM, nullptr, wg, lane); }
    int cur = 0;
    transpose_matrix(P.w_in, INC, DM, 2048, (bf16_t*)(P.ws + W_IN), scr, cur, gw, NGW, lane);
    transpose_matrix(P.w_in + 2056, INC, DM, 2048, (bf16_t*)(P.ws + W_IN) + (size_t)2048 * DM, scr, cur, gw, NGW, lane);
    transpose_matrix(P.w_out, DM, DM, DM, (bf16_t*)(P.ws + W_OUT), scr, cur, gw, NGW, lane);
    transpose_matrix(P.wq, DM, DM, DM, (bf16_t*)(P.ws + W_Q), scr, cur, gw, NGW, lane);
    transpose_matrix(P.wk, DM, DM, DM, (bf16_t*)(P.ws + W_K), scr, cur, gw, NGW, lane);
    transpose_matrix(P.wv, DM, DM, DM, (bf16_t*)(P.ws + W_V), scr, cur, gw, NGW, lane);
    transpose_matrix(P.wo, DM, DM, DM, (bf16_t*)(P.ws + W_O), scr, cur, gw, NGW, lane);
    transpose_matrix(P.w1, DFF, DM, DFF, (bf16_t*)(P.ws + W_1), scr, cur, gw, NGW, lane);
    transpose_matrix(P.w2, DM, DFF, DM, (bf16_t*)(P.ws + W_2), scr, cur, gw, NGW, lane);
    { bf16_t* VT = (bf16_t*)(P.ws + W_VTS);
      for (int it = gw; it < 128 * 32; it += NGW) { const int bh = it >> 5, sub = it & 31, b = bh >> 2, h = bh & 3, kb = sub >> 3, nb = sub & 7;
          transpose_item(P.cache_v + (size_t)b * 256 * 1024 + h * 256, 1024, VT + (size_t)bh * 65536, 256, scr, kb * 64, nb * 32, lane); } }
    { bf16_t* KB = (bf16_t*)(P.ws + W_KBS); const size_t n8 = (size_t)32 * 256 * 1024 / 8;
      for (size_t i = (size_t)blockIdx.x * 512 + tid; i < n8; i += (size_t)gridDim.x * 512) { const f32x4 a = *(const f32x4*)(P.cache_k + i * 8), b = *(const f32x4*)(P.cache_k + i * 8 + 4);
          u32x4 o; o.x = pk2(a.x, a.y); o.y = pk2(a.z, a.w); o.z = pk2(b.x, b.y); o.w = pk2(b.z, b.w); *(u32x4*)(KB + i * 8) = o; } }
    (void)WS;
}

DI void mlstm_seq(const Params& P, LAS unsigned char* lds, int b, int h, bool sample) {
    const int tid = get_tid(), lane = tid & 63, w = tid >> 6;
    LAS bf16_t* Qs = (LAS bf16_t*)(lds + 0);
    LAS bf16_t* Ks = (LAS bf16_t*)(lds + 17408);
    LAS bf16_t* Vt = (LAS bf16_t*)(lds + 34816);
    LAS bf16_t* Kwt = (LAS bf16_t*)(lds + 53248);
    LAS bf16_t* C0t = (LAS bf16_t*)(lds + 71680);
    LAS bf16_t* Sm = (LAS bf16_t*)(lds + 106496);
    LAS float* Hf = (LAS float*)(lds + 115712);
    LAS float* sm = (LAS float*)(lds + 149504);
    LAS float *sm_a = sm, *sm_bm = sm + 64, *sm_wi = sm + 128, *sm_ws = sm + 192, *sm_en = sm + 256, *sm_qn = sm + 320, *sm_rs = sm + 384  ,
              *sm_n0 = sm + 640  , *sm_np = sm + 768  , *sm_misc = sm + 1280;
    const bf16_t* PROJ = (const bf16_t*)(P.ws + W_PROJ); const float* GT = (const float*)(P.ws + W_GATES); bf16_t* HC = (bf16_t*)(P.ws + W_HCAT);
    const int row0 = sample ? NP + b * TS : b * SEQ, nchunks = sample ? 1 : 64, valid = sample ? TS : 64, bh = b * 4 + h;
    const float igb = P.ig_b[h], fgb = P.fg_b[h];
    f32x4 accs[8]; float m0 = 0.f;
    if (sample) { const float* C0 = P.st_C + (size_t)bh * 16384;
#pragma unroll
        for (int j = 0; j < 8; ++j) { const int dk = j * 16 + (lane & 15), dv = w * 16 + (lane >> 4) * 4; accs[j] = *(const f32x4*)(C0 + dk * 128 + dv); }
        if (tid < 128) sm_n0[tid] = P.st_n[bh * 128 + tid];
        m0 = P.st_m[bh];
    } else {
#pragma unroll
        for (int j = 0; j < 8; ++j) accs[j] = (f32x4){0.f, 0.f, 0.f, 0.f};
        if (tid < 128) sm_n0[tid] = 0.f;
    }
#pragma unroll
    for (int j = 0; j < 8; ++j)
#pragma unroll
        for (int r = 0; r < 4; ++r) C0t[(w * 16 + (lane >> 4) * 4 + r) * 136 + j * 16 + (lane & 15)] = f2bf(accs[j][r]);
    __syncthreads();
    for (int c = 0; c < nchunks; ++c) {
        const int r0 = row0 + c * 64;
        if (w == 0) {
            const int t = lane; float ig = -INFINITY, lf = 0.f;
            if (t < valid) { const float* gr = GT + (size_t)(r0 + t) * 16; ig = gr[h] + igb; const float f = gr[4 + h] + fgb; lf = fminf(f, 0.f) - log1pf(expf(-fabsf(f))); }
            float bc = lf;
#pragma unroll
            for (int o = 1; o < 64; o <<= 1) { const float u = __shfl_up(bc, o); if (lane >= o) bc += u; }
            const float a = ig - bc; float pm = a;
#pragma unroll
            for (int o = 1; o < 64; o <<= 1) { const float u = __shfl_up(pm, o); if (lane >= o) pm = fmaxf(pm, u); }
            const float mt = bc + fmaxf(m0, pm);
            const float blast = __shfl(bc, 63), mlast = __shfl(mt, 63);
            sm_a[t] = a; sm_bm[t] = bc - mt; sm_wi[t] = expf(bc + m0 - mt); sm_ws[t] = expf(blast + a - mlast) * SCALE_H; sm_en[t] = expf(-mt);
            if (lane == 0) { sm_misc[0] = expf(blast + m0 - mlast); sm_misc[1] = mlast; }
        }
        __syncthreads();
#pragma unroll 1
        for (int e = 0; e < 2; ++e) { const int i = tid + 512 * e, t = i >> 4, ch = i & 15;
            u32x4 q4 = (u32x4){0u, 0u, 0u, 0u}, k4 = q4, v4 = q4;
            if (t < valid) { const bf16_t* pr = PROJ + (size_t)(r0 + t) * NMAIN + h * 128 + ch * 8; q4 = *(const u32x4*)pr; k4 = *(const u32x4*)(pr + 512); v4 = *(const u32x4*)(pr + 1024); }
            *(LAS u32x4*)(Qs + t * 136 + ch * 8) = q4; *(LAS u32x4*)(Ks + t * 136 + ch * 8) = k4;
            const float wsv = sm_ws[t];
#pragma unroll
            for (int j = 0; j < 4; ++j) { const unsigned ku = k4[j], vu = v4[j];
                Kwt[(ch * 8 + 2 * j) * 72 + t] = f2bf(bflo(ku) * wsv); Kwt[(ch * 8 + 2 * j + 1) * 72 + t] = f2bf(bfhi(ku) * wsv);
                Vt[(ch * 8 + 2 * j) * 72 + t] = (bf16_t)(vu & 0xffffu); Vt[(ch * 8 + 2 * j + 1) * 72 + t] = (bf16_t)(vu >> 16); } }
        __syncthreads();
        { const int t = tid >> 3, part = tid & 7; float s = 0.f;
#pragma unroll
          for (int j = 0; j < 16; ++j) s += bf2f(Qs[t * 136 + part * 16 + j]) * sm_n0[part * 16 + j];
          s += __shfl_xor(s, 1); s += __shfl_xor(s, 2); s += __shfl_xor(s, 4);
          if (part == 0) sm_qn[t] = s; }
        { const int dk = tid & 127, pq = tid >> 7; float s = 0.f;
#pragma unroll
          for (int j = 0; j < 16; ++j) { const int ss = pq * 16 + j; s += sm_ws[ss] * bf2f(Ks[ss * 136 + dk]); }
          sm_np[pq * 128 + dk] = s; }
#pragma unroll 1
        for (int e = 0; e < 2; ++e) { const int idx = w * 2 + e, ti = idx >> 2, si = idx & 3; f32x4 acc = (f32x4){0.f, 0.f, 0.f, 0.f};
            if (si <= ti) acc = mm16<128>(Qs + ti * 16 * 136, 136, Ks + si * 16 * 136, 136, acc, lane);
            const int s = si * 16 + (lane & 15); const float as = sm_a[s]; float rs[4];
#pragma unroll
            for (int r = 0; r < 4; ++r) { const int t = ti * 16 + (lane >> 4) * 4 + r; const float val = (s <= t) ? acc[r] * SCALE_H * __expf(sm_bm[t] + as) : 0.f; Sm[t * 72 + s] = f2bf(val); rs[r] = val; }
#pragma unroll
            for (int r = 0; r < 4; ++r) { rs[r] += __shfl_xor(rs[r], 1); rs[r] += __shfl_xor(rs[r], 2); rs[r] += __shfl_xor(rs[r], 4); rs[r] += __shfl_xor(rs[r], 8); }
            if ((lane & 15) == 0) {
#pragma unroll
                for (int r = 0; r < 4; ++r) sm_rs[si * 64 + ti * 16 + (lane >> 4) * 4 + r] = rs[r]; } }
        __syncthreads();
#pragma unroll 1
        for (int e = 0; e < 4; ++e) { const int idx = w * 4 + e, ti = idx >> 3, di = idx & 7;
            f32x4 acc = mm16<128>(Qs + ti * 16 * 136, 136, C0t + di * 16 * 136, 136, (f32x4){0.f, 0.f, 0.f, 0.f}, lane);
#pragma unroll
            for (int r = 0; r < 4; ++r) acc[r] *= sm_wi[ti * 16 + (lane >> 4) * 4 + r];
            acc = mm16<64>(Sm + ti * 16 * 72, 72, Vt + di * 16 * 72, 72, acc, lane);
#pragma unroll
            for (int r = 0; r < 4; ++r) { const int t = ti * 16 + (lane >> 4) * 4 + r;
                const float den = sm_wi[t] * sm_qn[t] + ((sm_rs[t] + sm_rs[64 + t]) + (sm_rs[128 + t] + sm_rs[192 + t]));
                Hf[t * 132 + di * 16 + (lane & 15)] = acc[r] / fmaxf(fabsf(den), sm_en[t]); } }
        __syncthreads();
        { const int t = tid >> 3, part = tid & 7; float hv[16]; float ss = 0.f;
#pragma unroll
          for (int j = 0; j < 16; ++j) { hv[j] = Hf[t * 132 + part * 16 + j]; ss += hv[j] * hv[j]; }
          ss += __shfl_xor(ss, 1); ss += __shfl_xor(ss, 2); ss += __shfl_xor(ss, 4);
          const float rs = rsqrtf(ss * (1.f / 128.f) + EPS);
          if (t < valid) { const bf16_t* oa = PROJ + (size_t)(r0 + t) * NMAIN + 1536 + h * 128 + part * 16; const u32x4 o0 = *(const u32x4*)oa, o1 = *(const u32x4*)(oa + 8);
              const float* nw = P.mlstm_norm_w + part * 16; u32x4 r0v, r1v;
#pragma unroll
              for (int j = 0; j < 4; ++j) { const float a0 = hv[2 * j] * rs * nw[2 * j] * sigmoidf_(bflo(o0[j])), a1 = hv[2 * j + 1] * rs * nw[2 * j + 1] * sigmoidf_(bfhi(o0[j])); r0v[j] = pk2(a0, a1);
                  const float b0 = hv[8 + 2 * j] * rs * nw[8 + 2 * j] * sigmoidf_(bflo(o1[j])), b1 = hv[9 + 2 * j] * rs * nw[9 + 2 * j] * sigmoidf_(bfhi(o1[j])); r1v[j] = pk2(b0, b1); }
              bf16_t* op = HC + (size_t)(r0 + t) * DM + h * 128 + part * 16; *(u32x4*)op = r0v; *(u32x4*)(op + 8) = r1v; } }
        { const float d0 = sm_misc[0];
#pragma unroll
          for (int j = 0; j < 8; ++j) { accs[j] = accs[j] * d0; accs[j] = mm16<64>(Vt + w * 16 * 72, 72, Kwt + j * 16 * 72, 72, accs[j], lane);
#pragma unroll
              for (int r = 0; r < 4; ++r) C0t[(w * 16 + (lane >> 4) * 4 + r) * 136 + j * 16 + (lane & 15)] = f2bf(accs[j][r]); }
          if (tid < 128) sm_n0[tid] = d0 * sm_n0[tid] + ((sm_np[tid] + sm_np[128 + tid]) + (sm_np[256 + tid] + sm_np[384 + tid]));
          m0 = sm_misc[1]; }
        __syncthreads();
    }
    { float* Co = P.out + (sample ? O_SC : O_PC) + (size_t)bh * 16384;
#pragma unroll
      for (int j = 0; j < 8; ++j) { const int dk = j * 16 + (lane & 15), dv = w * 16 + (lane >> 4) * 4; *(f32x4*)(Co + dk * 128 + dv) = accs[j]; }
      if (tid < 128) P.out[(sample ? O_SN : O_PN) + bh * 128 + tid] = sm_n0[tid];
      if (tid == 0) P.out[(sample ? O_SM : O_PM) + bh] = m0; }
    __syncthreads();
}

DI void gdn_seq(const Params& P, LAS unsigned char* lds, int b, int h, bool sample) {
    const int tid = get_tid(), lane = tid & 63, w = tid >> 6;
    LAS bf16_t* Qs = (LAS bf16_t*)(lds + 0);
    LAS bf16_t* Ks = (LAS bf16_t*)(lds + 17408);
    LAS bf16_t* Wt = Ks;
    LAS bf16_t* Kdt = (LAS bf16_t*)(lds + 35840);
    LAS bf16_t* S0t = (LAS bf16_t*)(lds + 54272);
    LAS bf16_t* QKd = (LAS bf16_t*)(lds + 89088);
    LAS bf16_t* Am = (LAS bf16_t*)(lds + 98304);
    LAS float* Tinv = (LAS float*)(lds + 107520);
    LAS float* Adg = (LAS float*)(lds + 111872);
    LAS float* Rf = (LAS float*)(lds + 116224);
    LAS float* sm = (LAS float*)(lds + 150016);
    LAS float *sm_G = sm, *sm_gam = sm + 64, *sm_beta = sm + 128, *sm_bg = sm + 192, *sm_kd = sm + 256, *sm_misc = sm + 320;
    const bf16_t* PROJ = (const bf16_t*)(P.ws + W_PROJ); const float* GT = (const float*)(P.ws + W_GATES); bf16_t* HC = (bf16_t*)(P.ws + W_HCAT);
    const int row0 = sample ? NP + b * TS : b * SEQ, nchunks = sample ? 1 : 64, valid = sample ? TS : 64, bh = b * 4 + h;
    const float Aexp = expf(P.A_log[h]), dtb = P.dt_bias[h];
    f32x4 accs[8];
    if (sample) { const float* S0 = P.st_S + (size_t)bh * 16384;
#pragma unroll
        for (int j = 0; j < 8; ++j) { const int dk = j * 16 + (lane & 15), dv = w * 16 + (lane >> 4) * 4; accs[j] = *(const f32x4*)(S0 + dk * 128 + dv); }
    } else {
#pragma unroll
        for (int j = 0; j < 8; ++j) accs[j] = (f32x4){0.f, 0.f, 0.f, 0.f};
    }
#pragma unroll
    for (int j = 0; j < 8; ++j)
#pragma unroll
        for (int r = 0; r < 4; ++r) S0t[(w * 16 + (lane >> 4) * 4 + r) * 136 + j * 16 + (lane & 15)] = f2bf(accs[j][r]);
    __syncthreads();
    for (int c = 0; c < nchunks; ++c) {
        const int r0 = row0 + c * 64;
        if (w == 0) { const int t = lane; float g = 0.f, beta = 0.f;
            if (t < valid) { const float* gr = GT + (size_t)(r0 + t) * 16; const float ab = gr[8 + h] + dtb; const float sp = fmaxf(ab, 0.f) + log1pf(expf(-fabsf(ab))); g = -Aexp * sp; beta = 1.f / (1.f + expf(-gr[12 + h])); }
            float G = g;
#pragma unroll
            for (int o = 1; o < 64; o <<= 1) { const float u = __shfl_up(G, o); if (lane >= o) G += u; }
            const float Gl = __shfl(G, 63); const float eg = expf(G);
            sm_G[t] = G; sm_gam[t] = eg; sm_beta[t] = beta; sm_bg[t] = beta * eg; sm_kd[t] = expf(Gl - G);
            if (lane == 0) sm_misc[0] = expf(Gl); }
        __syncthreads();
#pragma unroll 1
        for (int which = 0; which < 3; ++which)
#pragma unroll 1
            for (int e = 0; e < 2; ++e) { const int i = tid + 512 * e, t = i >> 4, ch = i & 15, cb = which * 512 + h * 128 + ch * 8;
                float y[8];
#pragma unroll
                for (int j = 0; j < 8; ++j) y[j] = 0.f;
                if (t < valid) {
#pragma unroll
                    for (int r = 0; r < 4; ++r) { const int rr = t - 3 + r; float xv[8]; bool have = true;
                        if (rr >= 0 || c > 0) { const u32x4 x4 = *(const u32x4*)(PROJ + (size_t)(r0 + rr) * NMAIN + 2048 + cb);
#pragma unroll
                            for (int j = 0; j < 4; ++j) { xv[2 * j] = bflo(x4[j]); xv[2 * j + 1] = bfhi(x4[j]); } }
                        else if (sample) { const float* cp = P.st_conv + ((size_t)b * 3 + (3 + rr)) * 1536 + cb; const f32x4 a = *(const f32x4*)cp, bb = *(const f32x4*)(cp + 4);
                            xv[0] = a.x; xv[1] = a.y; xv[2] = a.z; xv[3] = a.w; xv[4] = bb.x; xv[5] = bb.y; xv[6] = bb.z; xv[7] = bb.w; }
                        else { have = false;
#pragma unroll
                            for (int j = 0; j < 8; ++j) xv[j] = 0.f; }
                        if (have) { const float* wp = P.conv_w + r * 1536 + cb; const f32x4 w0 = *(const f32x4*)wp, w1 = *(const f32x4*)(wp + 4);
                            y[0] += w0.x * xv[0]; y[1] += w0.y * xv[1]; y[2] += w0.z * xv[2]; y[3] += w0.w * xv[3]; y[4] += w1.x * xv[4]; y[5] += w1.y * xv[5]; y[6] += w1.z * xv[6]; y[7] += w1.w * xv[7]; } }
#pragma unroll
                    for (int j = 0; j < 8; ++j) y[j] = y[j] * sigmoidf_(y[j]);
                }
                if (which < 2) { float ss = 0.f;
#pragma unroll
                    for (int j = 0; j < 8; ++j) ss += y[j] * y[j];
                    ss += __shfl_xor(ss, 1); ss += __shfl_xor(ss, 2); ss += __shfl_xor(ss, 4); ss += __shfl_xor(ss, 8);
                    const float rn = rsqrtf(ss + EPS);
#pragma unroll
                    for (int j = 0; j < 8; ++j) y[j] *= rn;
                    u32x4 o; o.x = pk2(y[0], y[1]); o.y = pk2(y[2], y[3]); o.z = pk2(y[4], y[5]); o.w = pk2(y[6], y[7]);
                    if (which == 0) *(LAS u32x4*)(Qs + t * 136 + ch * 8) = o;
                    else { *(LAS u32x4*)(Ks + t * 136 + ch * 8) = o; const float kd = sm_kd[t];
#pragma unroll
                        for (int j = 0; j < 8; ++j) Kdt[(ch * 8 + j) * 72 + t] = f2bf(y[j] * kd); }
                } else { const float bt = sm_beta[t];
#pragma unroll
                    for (int j = 0; j < 8; ++j) Rf[t * 132 + ch * 8 + j] = bt * y[j]; } }
        __syncthreads();
#pragma unroll 1
        for (int e = 0; e < 4; ++e) { const int idx = w * 4 + e, kind = idx >> 4, ti = (idx >> 2) & 3, si = idx & 3; f32x4 acc = (f32x4){0.f, 0.f, 0.f, 0.f};
            if (si <= ti) acc = mm16<128>((kind ? Qs : Ks) + ti * 16 * 136, 136, Ks + si * 16 * 136, 136, acc, lane);
            const int s = si * 16 + (lane & 15); const float Gs = sm_G[s];
#pragma unroll
            for (int r = 0; r < 4; ++r) { const int t = ti * 16 + (lane >> 4) * 4 + r; const float dec = (s <= t) ? __expf(sm_G[t] - Gs) : 0.f;
                if (kind == 0) { const float val = (s < t) ? sm_beta[t] * dec * acc[r] : 0.f;
                    if (ti == si) { Adg[ti * 272 + (t & 15) * 17 + (s & 15)] = val; Am[t * 72 + s] = 0; } else Am[t * 72 + s] = f2bf(val); }
                else QKd[t * 72 + s] = f2bf(SCALE_H * dec * acc[r]); } }
        __syncthreads();
        if (w == 0) { const int blk = lane >> 4, cc = lane & 15; const LAS float* Ab = Adg + blk * 272; float X[16];
#pragma unroll
            for (int r = 0; r < 16; ++r) { float s = (cc == r) ? 1.f : 0.f;
#pragma unroll
                for (int q = 0; q < r; ++q) s -= Ab[r * 17 + q] * X[q];
                X[r] = s; }
#pragma unroll
            for (int r = 0; r < 16; ++r) Tinv[blk * 272 + r * 17 + cc] = X[r]; }
#pragma unroll 1
        for (int e = 0; e < 4; ++e) { const int idx = w * 4 + e, si = idx >> 3, di = idx & 7;
            const f32x4 acc = mm16<128>(Ks + si * 16 * 136, 136, S0t + di * 16 * 136, 136, (f32x4){0.f, 0.f, 0.f, 0.f}, lane);
#pragma unroll
            for (int r = 0; r < 4; ++r) { const int s = si * 16 + (lane >> 4) * 4 + r; Rf[s * 132 + di * 16 + (lane & 15)] -= sm_bg[s] * acc[r]; } }
        __syncthreads();
        for (int i = tid; i < 1152; i += 512) *(LAS u32x4*)((LAS unsigned char*)Wt + i * 16) = (u32x4){0u, 0u, 0u, 0u};
        __syncthreads();
#pragma unroll 1
        for (int i = 0; i < 4; ++i) {
            if (i > 0) { f32x4 acc = (f32x4){0.f, 0.f, 0.f, 0.f};
                if (i == 3) acc = mm16<64>(Am + i * 16 * 72, 72, Wt + w * 16 * 72, 72, acc, lane); else acc = mm16<32>(Am + i * 16 * 72, 72, Wt + w * 16 * 72, 72, acc, lane);
#pragma unroll
                for (int r = 0; r < 4; ++r) { const int s = i * 16 + (lane >> 4) * 4 + r; Rf[s * 132 + w * 16 + (lane & 15)] -= acc[r]; }
                __syncthreads(); }
            { const int dv = tid & 127, rq = tid >> 7; float Rv[16];
#pragma unroll
              for (int q = 0; q < 16; ++q) Rv[q] = Rf[(i * 16 + q) * 132 + dv];
              float wv[4];
#pragma unroll
              for (int rr = 0; rr < 4; ++rr) { const LAS float* tr = Tinv + i * 272 + (rq * 4 + rr) * 17; float s = 0.f;
#pragma unroll
                  for (int q = 0; q < 16; ++q) s += tr[q] * Rv[q];
                  wv[rr] = s; }
              u32x2 o; o.x = pk2(wv[0], wv[1]); o.y = pk2(wv[2], wv[3]); *(LAS u32x2*)(Wt + dv * 72 + i * 16 + rq * 4) = o; }
            __syncthreads();
        }
#pragma unroll 1
        for (int e = 0; e < 4; ++e) { const int idx = w * 4 + e, ti = idx >> 3, di = idx & 7;
            f32x4 acc = mm16<128>(Qs + ti * 16 * 136, 136, S0t + di * 16 * 136, 136, (f32x4){0.f, 0.f, 0.f, 0.f}, lane);
#pragma unroll
            for (int r = 0; r < 4; ++r) acc[r] *= SCALE_H * sm_gam[ti * 16 + (lane >> 4) * 4 + r];
            acc = mm16<64>(QKd + ti * 16 * 72, 72, Wt + di * 16 * 72, 72, acc, lane);
#pragma unroll
            for (int r = 0; r < 4; ++r) Rf[(ti * 16 + (lane >> 4) * 4 + r) * 132 + di * 16 + (lane & 15)] = acc[r]; }
        __syncthreads();
        { const float dG = sm_misc[0];
#pragma unroll
          for (int j = 0; j < 8; ++j) { accs[j] = accs[j] * dG; accs[j] = mm16<64>(Wt + w * 16 * 72, 72, Kdt + j * 16 * 72, 72, accs[j], lane);
#pragma unroll
              for (int r = 0; r < 4; ++r) S0t[(w * 16 + (lane >> 4) * 4 + r) * 136 + j * 16 + (lane & 15)] = f2bf(accs[j][r]); } }
        { const int t = tid >> 3, part = tid & 7; float hv[16]; float ss = 0.f;
#pragma unroll
          for (int j = 0; j < 16; ++j) { hv[j] = Rf[t * 132 + part * 16 + j]; ss += hv[j] * hv[j]; }
          ss += __shfl_xor(ss, 1); ss += __shfl_xor(ss, 2); ss += __shfl_xor(ss, 4);
          const float rs = rsqrtf(ss * (1.f / 128.f) + EPS);
          if (t < valid) { const bf16_t* zp = PROJ + (size_t)(r0 + t) * NMAIN + 3584 + h * 128 + part * 16; const u32x4 o0 = *(const u32x4*)zp, o1 = *(const u32x4*)(zp + 8);
              const float* nw = P.gdn_norm_w + part * 16; u32x4 r0v, r1v;
#pragma unroll
              for (int j = 0; j < 4; ++j) { const float z0 = bflo(o0[j]), z1 = bfhi(o0[j]), z2 = bflo(o1[j]), z3 = bfhi(o1[j]);
                  const float a0 = hv[2 * j] * rs * nw[2 * j] * z0 * sigmoidf_(z0), a1 = hv[2 * j + 1] * rs * nw[2 * j + 1] * z1 * sigmoidf_(z1); r0v[j] = pk2(a0, a1);
                  const float b0 = hv[8 + 2 * j] * rs * nw[8 + 2 * j] * z2 * sigmoidf_(z2), b1 = hv[9 + 2 * j] * rs * nw[9 + 2 * j] * z3 * sigmoidf_(z3); r1v[j] = pk2(b0, b1); }
              bf16_t* op = HC + (size_t)(r0 + t) * DM + 512 + h * 128 + part * 16; *(u32x4*)op = r0v; *(u32x4*)(op + 8) = r1v; } }
        __syncthreads();
    }
    { float* So = P.out + (sample ? O_SS : O_PS) + (size_t)bh * 16384;
#pragma unroll
      for (int j = 0; j < 8; ++j) { const int dk = j * 16 + (lane & 15), dv = w * 16 + (lane >> 4) * 4; *(f32x4*)(So + dk * 128 + dv) = accs[j]; }
      const int rl = sample ? row0 + TS - 3 : row0 + SEQ - 3; float* co = P.out + (sample ? O_SCONV : O_PCONV) + (size_t)b * 3 * 1536;
      for (int i = tid; i < 3 * 384; i += 512) { const int j = i / 384, q = i % 384, which = q >> 7, d = q & 127, cb = which * 512 + h * 128 + d;
          co[j * 1536 + cb] = bf2f(PROJ[(size_t)(rl + j) * NMAIN + 2048 + cb]); } }
    __syncthreads();
}

DI void phase2(const Params& P, LAS unsigned char* lds) {
    const int wg = blockIdx.x, G = gridDim.x;
    for (int it = wg; it < 384; it += G) {
        const bool sample = it >= 128; const int kind = sample ? (it >= 256) : (it >= 64);
        const int loc = sample ? (it - 128) & 127 : it & 63;
        if (kind == 0) mlstm_seq(P, lds, loc >> 2, loc & 3, sample); else gdn_seq(P, lds, loc >> 2, loc & 3, sample);
    }
    if (wg >= 128 || G <= 128) { const int nw = G > 128 ? G - 128 : G, me = G > 128 ? wg - 128 : wg, tid = get_tid(), lane = tid & 63, wave = tid >> 6;
        const float* mk = P.out + O_PMK; const float* mv = P.out + O_PMV; bf16_t* KB = (bf16_t*)(P.ws + W_KBP); bf16_t* VT = (bf16_t*)(P.ws + W_VTP);
        const size_t n8 = (size_t)4096 * 1024 / 8;
        for (size_t i = (size_t)me * 512 + tid; i < n8; i += (size_t)nw * 512) { const f32x4 a = *(const f32x4*)(mk + i * 8), b = *(const f32x4*)(mk + i * 8 + 4);
            u32x4 o; o.x = pk2(a.x, a.y); o.y = pk2(a.z, a.w); o.z = pk2(b.x, b.y); o.w = pk2(b.z, b.w); *(u32x4*)(KB + i * 8) = o; }
        LAS float* scr = (LAS float*)(lds + wave * 8448);
        for (int it = me * 8 + wave; it < 64 * 32; it += nw * 8) { const int bh = it >> 5, sub = it & 31, b = bh >> 2, h = bh & 3, kb = sub >> 3, nb = sub & 7;
            transpose_item(mv + (size_t)b * 256 * 1024 + h * 256, 1024, VT + (size_t)bh * 65536, 256, scr, kb * 64, nb * 32, lane); }
    }
}

DI void phase_attn(const Params& P, LAS unsigned char* lds) {
    const int tid = get_tid(), lane = tid & 63, w = tid >> 6;
    LAS bf16_t* Qs = (LAS bf16_t*)(lds + 0);
    LAS bf16_t* KVs = (LAS bf16_t*)(lds + 33792);
    LAS float* Sf = (LAS float*)(lds + 67584);
    const bf16_t* QB = (const bf16_t*)(P.ws + W_PROJ);
    bf16_t* ATT = (bf16_t*)(P.ws + W_HCAT);
    for (int item = blockIdx.x; item < 4096 + 128; item += gridDim.x) {
        int b, h, r0, valid; const bf16_t *KB, *VT;
        if (item < 4096) { const int bh = item >> 6, tile = item & 63; b = bh >> 2; h = bh & 3; r0 = b * SEQ + tile * 64; valid = 64;
            KB = (const bf16_t*)(P.ws + W_KBP) + (size_t)b * 256 * 1024; VT = (const bf16_t*)(P.ws + W_VTP) + (size_t)bh * 65536; }
        else { const int bh = item - 4096; b = bh >> 2; h = bh & 3; r0 = NP + b * TS; valid = TS;
            KB = (const bf16_t*)(P.ws + W_KBS) + (size_t)b * 256 * 1024; VT = (const bf16_t*)(P.ws + W_VTS) + (size_t)bh * 65536; }
#pragma unroll
        for (int e = 0; e < 4; ++e) { const int i = tid + 512 * e, t = i >> 5, ch = i & 31; u32x4 v = (u32x4){0u, 0u, 0u, 0u};
            if (t < valid) v = *(const u32x4*)(QB + (size_t)(r0 + t) * DM + h * 256 + ch * 8);
            *(LAS u32x4*)(Qs + t * 264 + ch * 8) = v; }
        for (int p = 0; p < 4; ++p) {
#pragma unroll
            for (int e = 0; e < 4; ++e) { const int i = tid + 512 * e, n = i >> 5, ch = i & 31;
                *(LAS u32x4*)(KVs + n * 264 + ch * 8) = *(const u32x4*)(KB + (size_t)(p * 64 + n) * 1024 + h * 256 + ch * 8); }
            __syncthreads();
#pragma unroll
            for (int e = 0; e < 2; ++e) { const int idx = w * 2 + e, ti = idx >> 2, ni = idx & 3;
                const f32x4 acc = mm16<256>(Qs + ti * 16 * 264, 264, KVs + ni * 16 * 264, 264, (f32x4){0.f, 0.f, 0.f, 0.f}, lane);
#pragma unroll
                for (int r = 0; r < 4; ++r) Sf[(ti * 16 + (lane >> 4) * 4 + r) * 260 + p * 64 + ni * 16 + (lane & 15)] = acc[r] * 0.0625f; }
            __syncthreads();
        }
        { const int t = tid >> 3, part = tid & 7; float sv[32]; float mx = -INFINITY;
#pragma unroll
          for (int j = 0; j < 32; ++j) { sv[j] = Sf[t * 260 + part * 32 + j]; mx = fmaxf(mx, sv[j]); }
          mx = fmaxf(mx, __shfl_xor(mx, 1)); mx = fmaxf(mx, __shfl_xor(mx, 2)); mx = fmaxf(mx, __shfl_xor(mx, 4));
          float sum = 0.f;
#pragma unroll
          for (int j = 0; j < 32; ++j) { sv[j] = __expf(sv[j] - mx); sum += sv[j]; }
          sum += __shfl_xor(sum, 1); sum += __shfl_xor(sum, 2); sum += __shfl_xor(sum, 4);
          const float inv = 1.f / sum;
#pragma unroll
          for (int j = 0; j < 4; ++j) { u32x4 o; o.x = pk2(sv[8 * j] * inv, sv[8 * j + 1] * inv); o.y = pk2(sv[8 * j + 2] * inv, sv[8 * j + 3] * inv);
              o.z = pk2(sv[8 * j + 4] * inv, sv[8 * j + 5] * inv); o.w = pk2(sv[8 * j + 6] * inv, sv[8 * j + 7] * inv);
              *(LAS u32x4*)(Qs + t * 264 + part * 32 + 8 * j) = o; } }
        for (int p = 0; p < 4; ++p) {
#pragma unroll
            for (int e = 0; e < 4; ++e) { const int i = tid + 512 * e, d = i >> 5, ch = i & 31;
                *(LAS u32x4*)(KVs + d * 264 + ch * 8) = *(const u32x4*)(VT + (size_t)(p * 64 + d) * 256 + ch * 8); }
            __syncthreads();
#pragma unroll
            for (int e = 0; e < 2; ++e) { const int idx = w * 2 + e, ti = idx >> 2, di = idx & 3;
                const f32x4 acc = mm16<256>(Qs + ti * 16 * 264, 264, KVs + di * 16 * 264, 264, (f32x4){0.f, 0.f, 0.f, 0.f}, lane);
#pragma unroll
                for (int r = 0; r < 4; ++r) { const int t = ti * 16 + (lane >> 4) * 4 + r;
                    if (t < valid) ATT[(size_t)(r0 + t) * DM + h * 256 + p * 64 + di * 16 + (lane & 15)] = f2bf(acc[r]); } }
            __syncthreads();
        }
    }
}

DI void phase_norm(const Params& P, const float* w) {
    const int tid = get_tid(), lane = tid & 63, gw = blockIdx.x * 8 + (tid >> 6), NGW = gridDim.x * 8;
    bf16_t* XN = (bf16_t*)(P.ws + W_XN);
    for (int r = gw; r < NTOK; r += NGW) norm_row<false>(P.out + (size_t)r * DM, w, XN + (size_t)r * DM, nullptr, nullptr, lane);
}
DI void phase_final(const Params& P) {
    const int tid = get_tid(), lane = tid & 63, gw = blockIdx.x * 8 + (tid >> 6), NGW = gridDim.x * 8;
    for (int r = gw; r < NTOK; r += NGW) { float* xr = P.out + (size_t)r * DM; f32x4 v[4]; float s = 0.f;
#pragma unroll
        for (int j = 0; j < 4; ++j) { v[j] = *(const f32x4*)(xr + 4 * lane + 256 * j); s += (v[j].x * v[j].x + v[j].y * v[j].y) + (v[j].z * v[j].z + v[j].w * v[j].w); }
        const float rstd = rsqrtf(wave_sum(s) * (1.f / DM) + EPS);
#pragma unroll
        for (int j = 0; j < 4; ++j) { const f32x4 wv = *(const f32x4*)(P.norm_final_w + 4 * lane + 256 * j); *(f32x4*)(xr + 4 * lane + 256 * j) = v[j] * rstd * wv; } }
}

__global__ __launch_bounds__(512, 2) void mega_fwd(Params P) {
    extern __shared__ __attribute__((aligned(16))) unsigned char shm[];
    LAS unsigned char* lds = (LAS unsigned char*)shm;
    cg::grid_group grid = cg::this_grid();
    unsigned char* ws = P.ws; float* out = P.out;
    phase0(P, lds);
    if (blockIdx.x == 0 && threadIdx.x == 0) { Params* t = (Params*)(ws + W_TAB); t->x_prompt = P.x_prompt; t->x_sample = P.x_sample; t->st_C = P.st_C; t->st_n = P.st_n; t->st_m = P.st_m; t->st_S = P.st_S; t->st_conv = P.st_conv; t->cache_k = P.cache_k; t->cache_v = P.cache_v; t->mem_prompt = P.mem_prompt; t->norm_mix_w = P.norm_mix_w; t->w_in = P.w_in; t->ig_b = P.ig_b; t->fg_b = P.fg_b; t->mlstm_norm_w = P.mlstm_norm_w; t->conv_w = P.conv_w; t->A_log = P.A_log; t->dt_bias = P.dt_bias; t->gdn_norm_w = P.gdn_norm_w; t->w_out = P.w_out; t->norm_x_w = P.norm_x_w; t->norm_mem_w = P.norm_mem_w; t->wq = P.wq; t->wk = P.wk; t->wv = P.wv; t->wo = P.wo; t->norm_ffn_w = P.norm_ffn_w; t->w1 = P.w1; t->w2 = P.w2; t->norm_final_w = P.norm_final_w; t->out = P.out; t->ws = P.ws; }
#if STOP_AFTER == 0
    return;
#endif
    grid.sync();
    const Params& T = *(const Params*)(ws + W_TAB);
    { EpiBf16<0> e; e.O = (bf16_t*)(ws + W_PROJ); e.ldc = NMAIN;
      run_gemm(lds, (const bf16_t*)(ws + W_XN), (const bf16_t*)(ws + W_IN), NTOK, NMAIN, DM, e, 0);
      EpiF32 ek; ek.C = out + O_PMK; ek.ldc = DM; run_gemm(lds, (const bf16_t*)(ws + W_MN), (const bf16_t*)(ws + W_K), 4096, DM, DM, ek, 32);
      EpiF32 ev; ev.C = out + O_PMV; ev.ldc = DM; run_gemm(lds, (const bf16_t*)(ws + W_MN), (const bf16_t*)(ws + W_V), 4096, DM, DM, ev, 96); }
#if STOP_AFTER == 1
    return;
#endif
#if STOP_AFTER == 101
    grid.sync();
    { const bf16_t* PJ = (const bf16_t*)(ws + W_PROJ); const float* GTp = (const float*)(ws + W_GATES);
      for (size_t i = (size_t)blockIdx.x * 512 + threadIdx.x; i < (size_t)NTOK * DM; i += (size_t)gridDim.x * 512) out[i] = bf2f(PJ[i * 4 + ((i >> 10) & 3)]);
      for (size_t i = (size_t)blockIdx.x * 512 + threadIdx.x; i < (size_t)NTOK * 16; i += (size_t)gridDim.x * 512) out[O_PC + i] = GTp[i]; }
    return;
#endif
    grid.sync();
    phase2(T, lds);
#if STOP_AFTER == 2
    return;
#endif
    grid.sync();
    { EpiRes e; e.out = out; e.resP = T.x_prompt; e.resS = T.x_sample; run_gemm(lds, (const bf16_t*)(ws + W_HCAT), (const bf16_t*)(ws + W_OUT), NTOK, DM, DM, e, 0); }
#if STOP_AFTER == 3
    return;
#endif
    grid.sync();
    phase_norm(T, T.norm_x_w);
#if STOP_AFTER == 4
    return;
#endif
    grid.sync();
    { EpiBf16<0> e; e.O = (bf16_t*)(ws + W_PROJ); e.ldc = DM; run_gemm(lds, (const bf16_t*)(ws + W_XN), (const bf16_t*)(ws + W_Q), NTOK, DM, DM, e, 0); }
#if STOP_AFTER == 5
    return;
#endif
    grid.sync();
    phase_attn(T, lds);
#if STOP_AFTER == 6
    return;
#endif
    grid.sync();
    { EpiRes e; e.out = out; e.resP = out; e.resS = out + (size_t)NP * DM; run_gemm(lds, (const bf16_t*)(ws + W_HCAT), (const bf16_t*)(ws + W_O), NTOK, DM, DM, e, 0); }
#if STOP_AFTER == 7
    return;
#endif
    grid.sync();
    phase_norm(T, T.norm_ffn_w);
#if STOP_AFTER == 8
    return;
#endif
    grid.sync();
    { EpiBf16<1> e; e.O = (bf16_t*)(ws + W_PROJ); e.ldc = DFF; run_gemm(lds, (const bf16_t*)(ws + W_XN), (const bf16_t*)(ws + W_1), NTOK, DFF, DM, e, 0); }
#if STOP_AFTER == 9
    return;
#endif
    grid.sync();
    { EpiRes e; e.out = out; e.resP = out; e.resS = out + (size_t)NP * DM; run_gemm(lds, (const bf16_t*)(ws + W_PROJ), (const bf16_t*)(ws + W_2), NTOK, DM, DFF, e, 0); }
#if STOP_AFTER == 10
    return;
#endif
    grid.sync();
    phase_final(T);
}

extern "C" void kernel_launch(void* const* d_in, const int* in_sizes, int n_in, void* d_out, int out_size, void* d_ws, size_t ws_size, hipStream_t stream) {
    static int grid_blocks = 0;
    if (grid_blocks == 0) {
        if (n_in != 30 || (size_t)out_size != O_END || ws_size < W_END) { fprintf(stderr, "kernel_launch: unexpected shapes: n_in %d out %d ws %zu (need %zu)\n", n_in, out_size, ws_size, (size_t)W_END); grid_blocks = -1; return; }
        int dev = 0, cus = 0, per_cu = 0;
        hipGetDevice(&dev);
        hipDeviceGetAttribute(&cus, hipDeviceAttributeMultiprocessorCount, dev);
        if (hipFuncSetAttribute((const void*)mega_fwd, hipFuncAttributeMaxDynamicSharedMemorySize, LDS_BYTES) != hipSuccess) { fprintf(stderr, "kernel_launch: hipFuncSetAttribute failed\n"); grid_blocks = -1; return; }
        if (hipOccupancyMaxActiveBlocksPerMultiprocessor(&per_cu, (const void*)mega_fwd, 512, LDS_BYTES) != hipSuccess || per_cu < 1) { fprintf(stderr, "kernel_launch: occupancy query gave %d\n", per_cu); (void)hipGetLastError(); grid_blocks = -1; return; }
        grid_blocks = cus * per_cu;
    }
    if (grid_blocks < 0) return;
    Params p{};
    const float* const* in = (const float* const*)d_in;
    p.x_prompt = in[0]; p.x_sample = in[1]; p.st_C = in[2]; p.st_n = in[3]; p.st_m = in[4]; p.st_S = in[5]; p.st_conv = in[6]; p.cache_k = in[7]; p.cache_v = in[8]; p.mem_prompt = in[9];
    p.norm_mix_w = in[10]; p.w_in = in[11]; p.ig_b = in[12]; p.fg_b = in[13]; p.mlstm_norm_w = in[14]; p.conv_w = in[15]; p.A_log = in[16]; p.dt_bias = in[17]; p.gdn_norm_w = in[18]; p.w_out = in[19];
    p.norm_x_w = in[20]; p.norm_mem_w = in[21]; p.wq = in[22]; p.wk = in[23]; p.wv = in[24]; p.wo = in[25]; p.norm_ffn_w = in[26]; p.w1 = in[27]; p.w2 = in[28]; p.norm_final_w = in[29];
    p.out = (float*)d_out; p.ws = (unsigned char*)d_ws;
    void* args[] = {&p};
    hipError_t e = hipLaunchCooperativeKernel((const void*)mega_fwd, dim3(grid_blocks), dim3(512), args, LDS_BYTES, stream);
    if (e != hipSuccess) fprintf(stderr, "cooperative launch failed: %s (grid %d)\n", hipGetErrorString(e), grid_blocks);
}
```

```cpp
#include <hip/hip_cooperative_groups.h>
#include <cstdio>
#include <cstdint>
#include <hip/hip_runtime.h>
namespace pg8 {
#define PG8_LAS __attribute__((address_space(3)))
typedef unsigned short bf16_t;
typedef short bf16x8 __attribute__((ext_vector_type(8)));
typedef float f32x4 __attribute__((ext_vector_type(4)));
typedef unsigned u32x4 __attribute__((ext_vector_type(4)));
constexpr int BM = 256, BK = 64, HALF = 128, HTB = HALF * BK * 2  , STAGE_BYTES = 8 * HTB, NXCD = 8, WGM = 8;

__host__ __device__ __forceinline__ int lds_byte(int r, int c) { const int st = (r >> 4) * 2 + (c >> 5), rr = r & 15, cc = c & 31, ob = rr * 64 + cc * 2; return st * 1024 + (ob ^ (((ob >> 9) & 1) << 5)); }
__host__ __device__ __forceinline__ void stage_rc(int b, int& R, int& C) { const int st = b / 1024, sb = b % 1024, swz = sb ^ (((sb >> 9) & 1) << 5); R = (st >> 1) * 16 + swz / 64; C = (st & 1) * 32 + (swz % 64) / 2; }
__host__ __device__ __forceinline__ int perm32(int rho) { const int n = rho >> 4, i = rho & 15; return 8 * (i >> 2) + 4 * n + (i & 3); }

struct Unit { int pm, pn; };
struct Gemm { const bf16_t* A; const bf16_t* Bt; int M, N, K; };

struct StaticOrder {
    int nM, nN, nwg, G, c;
    __host__ __device__ void init(int M, int N, int G_, int c_) { nM = M / BM; nN = N / BM; nwg = nM * nN; G = G_; c = c_; }
    __host__ __device__ bool next(int i, Unit& u) const {
        const long L = (long)i * G + c; if (L >= nwg) return false;
        int wgid = (int)L; { const int q = nwg / NXCD, r = nwg % NXCD, xcd = wgid % NXCD, off = wgid / NXCD; wgid = (xcd < r ? xcd * (q + 1) : r * (q + 1) + (xcd - r) * q) + off; }
        const int nig = WGM * nN, gid = wgid / nig, fm = gid * WGM, gsz = (nM - fm) < WGM ? (nM - fm) : WGM;
        u.pm = fm + ((wgid % nig) % gsz); u.pn = (wgid % nig) / gsz; return true;
    }
    __device__ __forceinline__ void a_ready(const Unit&) const {}
    __device__ __forceinline__ void done(const Unit&) const {}
};
__device__ __forceinline__ unsigned cvt_pk_bf16(float lo, float hi) { unsigned r; asm volatile("v_cvt_pk_bf16_f32 %0, %1, %2" : "=v"(r) : "v"(lo), "v"(hi)); return r; }

template <class Epi, class Sched, bool STAMP = false>
__device__ __forceinline__ void gemm_phase(PG8_LAS unsigned char* lds, const Gemm g, const Sched& S, const Epi& E, unsigned long long* stamps) {
    int tid_ = threadIdx.x; asm volatile("" : "+v"(tid_)); const int tid = tid_, wid = __builtin_amdgcn_readfirstlane(tid >> 6), lane = tid & 63, wr = wid >> 2, wc = wid & 3, fr = lane & 15, fq = lane >> 4;
    const int K = g.K, nt = K / BK;
    int ts_lo = 0, ts_hi = 0, nts = 0; const unsigned long long rt_entry = STAMP ? (unsigned long long)wall_clock64() : 0ull;
#define PG8_STAMP() do { if (STAMP && wid == 0 && nts < 64) { const unsigned long long _c = (unsigned long long)clock64(); \
        ts_lo = (lane == nts) ? (int)(unsigned)_c : ts_lo; ts_hi = (lane == nts) ? (int)(unsigned)(_c >> 32) : ts_hi; ++nts; } } while (0)
    PG8_STAMP();
    unsigned voffA[2], voffB[2];
#pragma unroll
    for (int i = 0; i < 2; ++i) { int R, C; stage_rc(tid * 16 + i * 8192, R, C); const int Rb = Epi::PERM ? ((R & ~31) + perm32(R & 31)) : R;
        voffA[i] = (unsigned)(R * K + C) * 2u; voffB[i] = (unsigned)(Rb * K + C) * 2u; }
    const size_t kstep = (size_t)(BK * 2);
    const size_t hstep = (size_t)HALF * K * 2;
    const size_t tstep = 2 * hstep;
    const unsigned ldsw = (unsigned)wid * 1024u;
    const int aoff = lds_byte(wr * 64 + fr, fq * 8), boff = lds_byte(wc * 32 + fr, fq * 8);
#define PG8_SA(b, h) (((b) * 2 + (h)) * HTB)
#define PG8_SB(b, h) ((4 + (b) * 2 + (h)) * HTB)
#define PG8_STAGE(bufoff, gbase, voff) do { _Pragma("unroll") for (int _i = 0; _i < 2; ++_i) \
        __builtin_amdgcn_global_load_lds((const unsigned*)((const char*)(gbase) + (voff)[_i]), (PG8_LAS unsigned*)(lds + (bufoff) + ldsw + _i * 8192), 16, 0, 0); } while (0)
#define PG8_LDA(dst, b, h) do { _Pragma("unroll") for (int m = 0; m < 4; ++m) _Pragma("unroll") for (int k = 0; k < 2; ++k) dst[m][k] = *(const PG8_LAS bf16x8*)(lds + PG8_SA(b, h) + aoff + m * 2048 + k * 1024); } while (0)
#define PG8_LDB(dst, b, h) do { _Pragma("unroll") for (int n = 0; n < 2; ++n) _Pragma("unroll") for (int k = 0; k < 2; ++k) dst[n][k] = *(const PG8_LAS bf16x8*)(lds + PG8_SB(b, h) + boff + n * 2048 + k * 1024); } while (0)
#define PG8_MMA(ai, bj, At, Bt) do { __builtin_amdgcn_s_setprio(1); _Pragma("unroll") for (int m = 0; m < 4; ++m) _Pragma("unroll") for (int n = 0; n < 2; ++n) _Pragma("unroll") for (int k = 0; k < 2; ++k) \
        acc[ai][bj][m][n] = __builtin_amdgcn_mfma_f32_16x16x32_bf16(Bt[n][k], At[m][k], acc[ai][bj][m][n], 0, 0, 0); __builtin_amdgcn_s_setprio(0); } while (0)
#define PG8_WAIT_V(n) asm volatile("s_waitcnt vmcnt(" #n ")" ::: "memory")
#define PG8_WAIT_L(n) asm volatile("s_waitcnt lgkmcnt(" #n ")" ::: "memory")
#define PG8_BAR __builtin_amdgcn_s_barrier()
#define PG8_SCHED __builtin_amdgcn_sched_barrier(0)
    Unit cur, nxt; int ui = 0;
    if (!S.next(0, cur)) return;
    f32x4 acc[2][2][4][2];
#pragma unroll
    for (int a = 0; a < 2; ++a)
#pragma unroll
        for (int b = 0; b < 2; ++b)
#pragma unroll
            for (int m = 0; m < 4; ++m)
#pragma unroll
                for (int n = 0; n < 2; ++n) acc[a][b][m][n] = (f32x4){0.f, 0.f, 0.f, 0.f};
    bf16x8 At[4][2], B0[2][2], B1[2][2];
    const char* cA = (const char*)g.A + (size_t)cur.pm * tstep; const char* cB = (const char*)g.Bt + (size_t)cur.pn * tstep;
    S.a_ready(cur);
    PG8_STAGE(PG8_SB(0, 0), cB, voffB); PG8_STAGE(PG8_SA(0, 0), cA, voffA); PG8_STAGE(PG8_SB(0, 1), cB + hstep, voffB); PG8_STAGE(PG8_SA(0, 1), cA + hstep, voffA);
    if (wr == 1) PG8_BAR;
    PG8_WAIT_V(4); PG8_BAR;
    PG8_STAGE(PG8_SB(1, 0), cB + kstep, voffB); PG8_STAGE(PG8_SA(1, 0), cA + kstep, voffA); PG8_STAGE(PG8_SB(1, 1), cB + hstep + kstep, voffB);
    PG8_WAIT_V(6); PG8_BAR;
    PG8_STAMP();
    for (;;) {
        const bool has_next = S.next(ui + 1, nxt);
        const char* nA = has_next ? (const char*)g.A + (size_t)nxt.pm * tstep : cA; const char* nB = has_next ? (const char*)g.Bt + (size_t)nxt.pn * tstep : cB;
        for (int t = 0; t < nt; t += 2) {
            const bool last = (t == nt - 2);
            const char* a1 = cA + (size_t)(t + 1) * kstep;
            const char* a2 = last ? nA : cA + (size_t)(t + 2) * kstep; const char* b2 = last ? nB : cB + (size_t)(t + 2) * kstep;
            const char* a3 = a2 + kstep; const char* b3 = b2 + kstep;
            if (last && has_next) S.a_ready(nxt);
            PG8_LDB(B0, 0, 0); PG8_SCHED; PG8_LDA(At, 0, 0); PG8_STAGE(PG8_SA(1, 1), a1 + hstep, voffA);
            PG8_WAIT_L(8); PG8_BAR; PG8_WAIT_L(0); PG8_MMA(0, 0, At, B0); PG8_BAR; PG8_SCHED;
            PG8_LDB(B1, 0, 1); PG8_STAGE(PG8_SB(0, 0), b2, voffB);
            PG8_BAR; PG8_WAIT_L(0); PG8_MMA(0, 1, At, B1); PG8_BAR;
            PG8_LDA(At, 0, 1); PG8_STAGE(PG8_SA(0, 0), a2, voffA);
            PG8_BAR; PG8_WAIT_L(0); PG8_MMA(1, 0, At, B0); PG8_BAR; PG8_SCHED;
            PG8_STAGE(PG8_SB(0, 1), b2 + hstep, voffB);
            PG8_WAIT_V(6); PG8_BAR; PG8_MMA(1, 1, At, B1); PG8_BAR;
            PG8_LDB(B0, 1, 0); PG8_SCHED; PG8_LDA(At, 1, 0); PG8_STAGE(PG8_SA(0, 1), a2 + hstep, voffA);
            PG8_WAIT_L(8); PG8_BAR; PG8_WAIT_L(0); PG8_MMA(0, 0, At, B0); PG8_BAR; PG8_SCHED;
            PG8_LDB(B1, 1, 1); PG8_STAGE(PG8_SB(1, 0), b3, voffB);
            PG8_BAR; PG8_WAIT_L(0); PG8_MMA(0, 1, At, B1); PG8_BAR;
            PG8_LDA(At, 1, 1); PG8_STAGE(PG8_SA(1, 0), a3, voffA);
            PG8_BAR; PG8_WAIT_L(0); PG8_MMA(1, 0, At, B0); PG8_BAR; PG8_SCHED;
            PG8_STAGE(PG8_SB(1, 1), b3 + hstep, voffB);
            PG8_WAIT_V(6); PG8_BAR; PG8_MMA(1, 1, At, B1); PG8_BAR;
        }
        PG8_STAMP();
        if constexpr (!Epi::AFTER_DRAIN) { E(acc, cur, wr, wc, fr, fq); S.done(cur); }
        PG8_STAMP();
        if (!has_next) break;
#pragma unroll
        for (int a = 0; a < 2; ++a)
#pragma unroll
            for (int b = 0; b < 2; ++b)
#pragma unroll
                for (int m = 0; m < 4; ++m)
#pragma unroll
                    for (int n = 0; n < 2; ++n) acc[a][b][m][n] = (f32x4){0.f, 0.f, 0.f, 0.f};
        cur = nxt; cA = nA; cB = nB; ++ui;
    }
    PG8_WAIT_V(0);
    if (wr == 0) PG8_BAR;
    PG8_BAR;
    if constexpr (Epi::AFTER_DRAIN) { E.fused(acc, cur, wr, wc, fr, fq, lds, wid, lane); S.done(cur); }
    PG8_STAMP();
    if (STAMP && wid == 0) { stamps[lane] = lane < nts ? (((unsigned long long)(unsigned)ts_hi << 32) | (unsigned)ts_lo) : 0ull;
        if (lane == 62) stamps[62] = rt_entry; if (lane == 63) stamps[63] = (unsigned long long)wall_clock64(); }
#undef PG8_STAMP
#undef PG8_SA
#undef PG8_SB
#undef PG8_STAGE
#undef PG8_LDA
#undef PG8_LDB
#undef PG8_MMA
#undef PG8_WAIT_V
#undef PG8_WAIT_L
#undef PG8_BAR
#undef PG8_SCHED
}
}

#ifndef STOP_AFTER
#define STOP_AFTER 99
#endif
namespace cg = cooperative_groups;
using pg8::bf16_t; using pg8::bf16x8; using pg8::f32x4; using pg8::u32x4; using pg8::Unit;
#define LAS __attribute__((address_space(3)))
#define DI __device__ __forceinline__
typedef unsigned u32x2 __attribute__((ext_vector_type(2)));

constexpr int DM = 1024, NP = 65536, NS = 512, NTOK = NP + NS, SEQ = 4096, NB_P = 16, NB_S = 32, TS = 16;
constexpr int INC = 4112, NMAIN = 4096, DFF = 4096, NMEM = 256;
constexpr float EPS = 1e-6f;
constexpr float SCALE_H = 0.08838834764831845f;
constexpr size_t O_Y = 0, O_PC = (size_t)NTOK * DM, O_PN = O_PC + 16 * 4 * 128 * 128, O_PM = O_PN + 16 * 4 * 128, O_PS = O_PM + 64,
                 O_PCONV = O_PS + 16 * 4 * 128 * 128, O_PMK = O_PCONV + 16 * 3 * 1536, O_PMV = O_PMK + (size_t)16 * 256 * 1024,
                 O_SC = O_PMV + (size_t)16 * 256 * 1024, O_SN = O_SC + 32 * 4 * 128 * 128, O_SM = O_SN + 32 * 4 * 128, O_SS = O_SM + 128,
                 O_SCONV = O_SS + 32 * 4 * 128 * 128, O_END = O_SCONV + 32 * 3 * 1536;
constexpr size_t W_IN = 0, W_OUT = W_IN + (size_t)NMAIN * DM * 2, W_Q = W_OUT + (size_t)DM * DM * 2, W_K = W_Q + (size_t)DM * DM * 2, W_V = W_K + (size_t)DM * DM * 2,
                 W_O = W_V + (size_t)DM * DM * 2, W_1 = W_O + (size_t)DM * DM * 2, W_2 = W_1 + (size_t)DFF * DM * 2,
                 W_PROJ = W_2 + (size_t)DFF * DM * 2, W_HCAT = W_PROJ + (size_t)NTOK * NMAIN * 2, W_GATES = W_HCAT + (size_t)NTOK * DM * 2,
                 W_MN = W_GATES + (size_t)NTOK * 16 * 4, W_KBP = W_MN + (size_t)4096 * DM * 2, W_VTP = W_KBP + (size_t)4096 * DM * 2,
                 W_KBS = W_VTP + (size_t)4096 * DM * 2, W_VTS = W_KBS + (size_t)8192 * DM * 2, W_TAB = W_VTS + (size_t)8192 * DM * 2,
                 W_XBS = W_TAB + 4096  , W_QS = W_XBS + (size_t)NS * DM * 2  , W_HS = W_QS + (size_t)NS * DM * 2  , W_CTL = W_HS + (size_t)NS * DFF * 2  , W_SQ1 = W_CTL + 8192, W_SQ2 = W_SQ1 + (size_t)NTOK * 64, W_RS1 = W_SQ2 + (size_t)NTOK * 64, W_RS2 = W_RS1 + (size_t)NTOK * 4, W_XN = W_RS2 + (size_t)NTOK * 4, W_QKVC = W_XN  , W_END = W_XN + (size_t)NTOK * 1536 * 2;
constexpr int LDS_BYTES = 156 * 1024;

struct Params {
    const float *x_prompt, *x_sample, *st_C, *st_n, *st_m, *st_S, *st_conv, *cache_k, *cache_v, *mem_prompt;
    const float *norm_mix_w, *w_in, *ig_b, *fg_b, *mlstm_norm_w, *conv_w, *A_log, *dt_bias, *gdn_norm_w, *w_out;
    const float *norm_x_w, *norm_mem_w, *wq, *wk, *wv, *wo, *norm_ffn_w, *w1, *w2, *norm_final_w;
    float* out; unsigned char* ws;
};

DI unsigned pk2(float lo, float hi) { unsigned r; asm("v_cvt_pk_bf16_f32 %0, %1, %2" : "=v"(r) : "v"(lo), "v"(hi)); return r; }
DI unsigned pk2a(float lo, float hi) { unsigned r; asm volatile("v_cvt_pk_bf16_f32 %0, %1, %2" : "=v"(r) : "v"(lo), "v"(hi)); return r; }
typedef short s16x4 __attribute__((ext_vector_type(4)));
typedef float f32x2_ __attribute__((ext_vector_type(2)));
typedef __bf16 bf16x2_ __attribute__((ext_vector_type(2)));
DI s16x4 pack4(f32x4 v) { const f32x2_ a = {v.x, v.y}, b = {v.z, v.w}; u32x2 u; u.x = __builtin_bit_cast(unsigned, __builtin_convertvector(a, bf16x2_)); u.y = __builtin_bit_cast(unsigned, __builtin_convertvector(b, bf16x2_)); return __builtin_bit_cast(s16x4, u); }
DI bf16_t f2bf(float f) { return __builtin_bit_cast(unsigned short, (__bf16)f); }
DI float bf2f(bf16_t b) { return __uint_as_float(((unsigned)b) << 16); }
DI float bflo(unsigned u) { return __uint_as_float(u << 16); }
DI float bfhi(unsigned u) { return __uint_as_float(u & 0xffff0000u); }
DI int get_tid() { int t = threadIdx.x; asm volatile("" : "+v"(t)); return t; }
DI float wave_sum(float v) {
#pragma unroll
    for (int o = 1; o < 64; o <<= 1) v += __shfl_xor(v, o);
    return v;
}
DI float sigmoidf_(float x) { return 1.f / (1.f + __expf(-x)); }
#define LDS_WAIT() asm volatile("s_waitcnt lgkmcnt(0)" ::: "memory")
DI void lds_barrier() { asm volatile("s_waitcnt lgkmcnt(0)" ::: "memory"); __builtin_amdgcn_s_barrier(); asm volatile("" ::: "memory"); }

template <int K> DI f32x4 mm16(const LAS bf16_t* A, int lda, const LAS bf16_t* B, int ldb, f32x4 acc, int lane) {
    const LAS bf16_t* pa = A + (lane & 15) * lda + (lane >> 4) * 8;
    const LAS bf16_t* pb = B + (lane & 15) * ldb + (lane >> 4) * 8;
#pragma unroll
    for (int k = 0; k < K; k += 32) {
        const bf16x8 a = *(const LAS bf16x8*)(pa + k), b = *(const LAS bf16x8*)(pb + k);
        acc = __builtin_amdgcn_mfma_f32_16x16x32_bf16(a, b, acc, 0, 0, 0);
    }
    return acc;
}

template <int ACT, bool ROWSCALE> struct EpiBf16 {
    static constexpr bool PERM = true, AFTER_DRAIN = false;
    bf16_t* O; int ldc; const float* rstd;
    DI void operator()(const f32x4 (&acc)[2][2][4][2], const Unit& u, int wr, int wc, int fr, int fq) const {
        const int row0 = u.pm * 256 + wr * 64 + fr, col0 = u.pn * 256 + wc * 32 + 8 * fq;
        float rsv[2][4];
        if (ROWSCALE) {
#pragma unroll
            for (int ai = 0; ai < 2; ++ai)
#pragma unroll
                for (int m = 0; m < 4; ++m) rsv[ai][m] = rsqrtf(rstd[row0 + ai * 128 + m * 16] * (1.f / DM) + EPS); }
#pragma unroll
        for (int ai = 0; ai < 2; ++ai)
#pragma unroll
            for (int m = 0; m < 4; ++m) { const int row = row0 + ai * 128 + m * 16; bf16_t* rowp = O + (size_t)row * ldc + col0; const float rs = ROWSCALE ? rsv[ai][m] : 1.f;
#pragma unroll
                for (int bj = 0; bj < 2; ++bj) { f32x4 v0 = acc[ai][bj][m][0], v1 = acc[ai][bj][m][1];
                    if (ROWSCALE) { v0 = v0 * rs; v1 = v1 * rs; }
                    if (ACT == 1) {
#pragma unroll
                        for (int e = 0; e < 4; ++e) { float a = fmaxf(v0[e], 0.f), b = fmaxf(v1[e], 0.f); v0[e] = a * a; v1[e] = b * b; } }
                    u32x4 o; o.x = pk2a(v0[0], v0[1]); o.y = pk2a(v0[2], v0[3]); o.z = pk2a(v1[0], v1[1]); o.w = pk2a(v1[2], v1[3]);
                    *(u32x4*)(rowp + bj * 128) = o; } }
    }
};
struct EpiF32 {
    static constexpr bool PERM = false, AFTER_DRAIN = false;
    float* C; int ldc;
    DI void operator()(const f32x4 (&acc)[2][2][4][2], const Unit& u, int wr, int wc, int fr, int fq) const {
        const int row0 = u.pm * 256 + wr * 64 + fr, col0 = u.pn * 256 + wc * 32 + 4 * fq;
#pragma unroll
        for (int ai = 0; ai < 2; ++ai)
#pragma unroll
            for (int m = 0; m < 4; ++m) { float* rowp = C + (size_t)(row0 + ai * 128 + m * 16) * ldc + col0;
#pragma unroll
                for (int bj = 0; bj < 2; ++bj)
#pragma unroll
                    for (int n = 0; n < 2; ++n) *(f32x4*)(rowp + bj * 128 + n * 16) = acc[ai][bj][m][n]; }
    }
};
struct EpiRes {
    static constexpr bool PERM = false, AFTER_DRAIN = false;
    float* out; const float* resP; const float* resS;
    DI void operator()(const f32x4 (&acc)[2][2][4][2], const Unit& u, int wr, int wc, int fr, int fq) const {
        const int row0 = u.pm * 256 + wr * 64 + fr, col0 = u.pn * 256 + wc * 32 + 4 * fq;
        const float* rbase = (u.pm < NP / 256) ? resP + (size_t)row0 * DM : resS + (size_t)(row0 - NP) * DM;
#pragma unroll
        for (int ai = 0; ai < 2; ++ai)
#pragma unroll
            for (int m = 0; m < 4; ++m) { const size_t ro = (size_t)(ai * 128 + m * 16) * DM + col0; const float* rp = rbase + ro; float* op = out + (size_t)row0 * DM + ro;
#pragma unroll
                for (int bj = 0; bj < 2; ++bj)
#pragma unroll
                    for (int n = 0; n < 2; ++n) *(f32x4*)(op + bj * 128 + n * 16) = *(const f32x4*)(rp + bj * 128 + n * 16) + acc[ai][bj][m][n]; }
    }
};
struct EpiResSq {
    static constexpr bool PERM = false, AFTER_DRAIN = false;
    float* out; const float* resP; const float* resS; bf16_t* XB; float* sq;
    DI void operator()(const f32x4 (&acc)[2][2][4][2], const Unit& u, int wr, int wc, int fr, int fq) const {
        const int row0 = u.pm * 256 + wr * 64 + fr, col0 = u.pn * 256 + wc * 32 + 4 * fq;
        const float* rbase = (u.pm < NP / 256) ? resP + (size_t)row0 * DM : resS + (size_t)(row0 - NP) * DM;
#pragma unroll
        for (int ai = 0; ai < 2; ++ai)
#pragma unroll
            for (int m = 0; m < 4; ++m) { const size_t ro = (size_t)(ai * 128 + m * 16) * DM + col0; const float* rp = rbase + ro; float* op = out + (size_t)row0 * DM + ro; bf16_t* xp = XB + (size_t)row0 * DM + ro;
                float ss = 0.f;
#pragma unroll
                for (int bj = 0; bj < 2; ++bj)
#pragma unroll
                    for (int n = 0; n < 2; ++n) { const f32x4 v = *(const f32x4*)(rp + bj * 128 + n * 16) + acc[ai][bj][m][n]; *(f32x4*)(op + bj * 128 + n * 16) = v;
                        ss += (v.x * v.x + v.y * v.y) + (v.z * v.z + v.w * v.w);
                        u32x2 o; o.x = pk2(v.x, v.y); o.y = pk2(v.z, v.w); *(u32x2*)(xp + bj * 128 + n * 16) = o; }
                ss += __shfl_xor(ss, 16); ss += __shfl_xor(ss, 32);
                if (fq == 0) sq[(size_t)(row0 + ai * 128 + m * 16) * 16 + u.pn * 4 + wc] = ss; }
    }
};
template <bool RESF32> struct EpiResB {
    static constexpr bool PERM = true, AFTER_DRAIN = false;
    const float* resF; const bf16_t* resB; bf16_t* XB; float* sq;
    DI void finish(f32x4 v0, f32x4 v1, float& ss, bf16_t* dst) const {
        ss += ((v0.x * v0.x + v0.y * v0.y) + (v0.z * v0.z + v0.w * v0.w)) + ((v1.x * v1.x + v1.y * v1.y) + (v1.z * v1.z + v1.w * v1.w));
        u32x4 o; o.x = pk2(v0.x, v0.y); o.y = pk2(v0.z, v0.w); o.z = pk2(v1.x, v1.y); o.w = pk2(v1.z, v1.w);
        *(u32x4*)dst = o; }
    DI void rowsum(float ss, int row, int fq) const {
        ss += __shfl_xor(ss, 16); ss += __shfl_xor(ss, 32);
        if (fq == 0 && sq) __hip_atomic_fetch_add(sq + row, ss, __ATOMIC_RELAXED, __HIP_MEMORY_SCOPE_AGENT); }
    DI void operator()(const f32x4 (&acc)[2][2][4][2], const Unit& u, int wr, int wc, int fr, int fq) const {
        const int row0 = u.pm * 256 + wr * 64 + fr, col0 = u.pn * 256 + wc * 32 + 8 * fq;
        if (!RESF32) {
#pragma unroll
            for (int ai = 0; ai < 2; ++ai) { u32x4 rr[4][2];
#pragma unroll
                for (int m = 0; m < 4; ++m)
#pragma unroll
                    for (int bj = 0; bj < 2; ++bj) rr[m][bj] = *(const u32x4*)(resB + (size_t)(row0 + ai * 128 + m * 16) * DM + col0 + bj * 128);
#pragma unroll
                for (int m = 0; m < 4; ++m) { const size_t ro = (size_t)(row0 + ai * 128 + m * 16) * DM + col0; float ss = 0.f;
#pragma unroll
                    for (int bj = 0; bj < 2; ++bj) { f32x4 v0 = acc[ai][bj][m][0], v1 = acc[ai][bj][m][1]; const u32x4 r = rr[m][bj];
                        v0.x += bflo(r.x); v0.y += bfhi(r.x); v0.z += bflo(r.y); v0.w += bfhi(r.y); v1.x += bflo(r.z); v1.y += bfhi(r.z); v1.z += bflo(r.w); v1.w += bfhi(r.w);
                        finish(v0, v1, ss, XB + ro + bj * 128); }
                    rowsum(ss, row0 + ai * 128 + m * 16, fq); } }
        } else {
#pragma unroll
            for (int ai = 0; ai < 2; ++ai) { f32x4 rf[4][2][2];
#pragma unroll
                for (int m = 0; m < 4; ++m)
#pragma unroll
                    for (int bj = 0; bj < 2; ++bj) { const float* rp = resF + (size_t)(row0 + ai * 128 + m * 16) * DM + col0 + bj * 128; rf[m][bj][0] = *(const f32x4*)rp; rf[m][bj][1] = *(const f32x4*)(rp + 4); }
#pragma unroll
                for (int m = 0; m < 4; ++m) { const size_t ro = (size_t)(row0 + ai * 128 + m * 16) * DM + col0; float ss = 0.f;
#pragma unroll
                    for (int bj = 0; bj < 2; ++bj) finish(acc[ai][bj][m][0] + rf[m][bj][0], acc[ai][bj][m][1] + rf[m][bj][1], ss, XB + ro + bj * 128);
                    rowsum(ss, row0 + ai * 128 + m * 16, fq); } }
        }
    }
};
template <class Epi> DI void run_gemm(LAS unsigned char* lds, const bf16_t* A, const bf16_t* Bt, int M, int N, int K, const Epi& E, int cshift, int G = 0, int c0 = 0) {
    pg8::Gemm g; g.A = A; g.Bt = Bt; g.M = M; g.N = N; g.K = K;
    if (G == 0) { G = (int)gridDim.x; c0 = (int)blockIdx.x; }
    pg8::StaticOrder S; S.init(M, N, G, (c0 + G - cshift) % G);
    pg8::gemm_phase<Epi, pg8::StaticOrder, false>(lds, g, S, E, nullptr);
    __syncthreads();
}

DI void transpose_item(const float* src, int ld, bf16_t* dst, int ldd, LAS float* scr, int k0, int n0, int lane, const float* ksc = nullptr) {
#pragma unroll
    for (int i = 0; i < 32; ++i) { const int kk = 2 * i + (lane >> 5); float x = src[(size_t)(k0 + kk) * ld + n0 + (lane & 31)]; if (ksc) x *= ksc[k0 + kk]; scr[kk * 33 + (lane & 31)] = x; }
    LDS_WAIT();
    const int c = lane & 7;
#pragma unroll
    for (int j = 0; j < 4; ++j) { const int n = (lane >> 3) + 8 * j; const LAS float* s = scr + (8 * c) * 33 + n;
        u32x4 o; o.x = pk2(s[0 * 33], s[1 * 33]); o.y = pk2(s[2 * 33], s[3 * 33]); o.z = pk2(s[4 * 33], s[5 * 33]); o.w = pk2(s[6 * 33], s[7 * 33]);
        *(u32x4*)(dst + (size_t)(n0 + n) * ldd + k0 + 8 * c) = o; }
    LDS_WAIT();
}
DI void load_row(f32x4 (&v)[4], const float* xrow, int lane) {
#pragma unroll
    for (int j = 0; j < 4; ++j) v[j] = *(const f32x4*)(xrow + 4 * lane + 256 * j);
}
template <bool GATES> DI void norm_row(f32x4 (&v)[4], const float* w, bf16_t* orow, float* grow, const LAS float* wg, int lane) {
    float s = 0.f;
#pragma unroll
    for (int j = 0; j < 4; ++j) s += (v[j].x * v[j].x + v[j].y * v[j].y) + (v[j].z * v[j].z + v[j].w * v[j].w);
    const float rstd = rsqrtf(wave_sum(s) * (1.f / DM) + EPS);
#pragma unroll
    for (int j = 0; j < 4; ++j) { const f32x4 wv = *(const f32x4*)(w + 4 * lane + 256 * j); v[j] = v[j] * rstd * wv;
        u32x2 o; o.x = pk2(v[j].x, v[j].y); o.y = pk2(v[j].z, v[j].w); *(u32x2*)(orow + 4 * lane + 256 * j) = o; }
    if (GATES) {
        float g[16];
#pragma unroll
        for (int gi = 0; gi < 16; ++gi) { float a = 0.f;
#pragma unroll
            for (int j = 0; j < 4; ++j) { const f32x4 ww = *(const LAS f32x4*)(wg + gi * 1024 + 4 * lane + 256 * j); a += (v[j].x * ww.x + v[j].y * ww.y) + (v[j].z * ww.z + v[j].w * ww.w); }
            g[gi] = a; }
#pragma unroll
        for (int i = 0; i < 8; ++i) { const bool up = lane & 1; const float send = up ? g[i] : g[i + 8], keep = up ? g[i + 8] : g[i]; g[i] = keep + __shfl_xor(send, 1); }
#pragma unroll
        for (int i = 0; i < 4; ++i) { const bool up = lane & 2; const float send = up ? g[i] : g[i + 4], keep = up ? g[i + 4] : g[i]; g[i] = keep + __shfl_xor(send, 2); }
#pragma unroll
        for (int i = 0; i < 2; ++i) { const bool up = lane & 4; const float send = up ? g[i] : g[i + 2], keep = up ? g[i + 2] : g[i]; g[i] = keep + __shfl_xor(send, 4); }
        { const bool up = lane & 8; const float send = up ? g[0] : g[1], keep = up ? g[1] : g[0]; g[0] = keep + __shfl_xor(send, 8); }
        g[0] += __shfl_xor(g[0], 16); g[0] += __shfl_xor(g[0], 32);
        const int idx = ((lane & 1) << 3) | ((lane & 2) << 1) | ((lane & 4) >> 1) | ((lane & 8) >> 3);
        if (lane < 16) grow[idx] = g[0];
    }
}
DI void norm_row2_gates(f32x4 (&v0)[4], f32x4 (&v1)[4], const float* w, bf16_t* orow0, bf16_t* orow1, float* grow0, float* grow1, const LAS float* wg, int lane) {
    float s0 = 0.f, s1 = 0.f;
#pragma unroll
    for (int j = 0; j < 4; ++j) { s0 += (v0[j].x * v0[j].x + v0[j].y * v0[j].y) + (v0[j].z * v0[j].z + v0[j].w * v0[j].w); s1 += (v1[j].x * v1[j].x + v1[j].y * v1[j].y) + (v1[j].z * v1[j].z + v1[j].w * v1[j].w); }
#pragma unroll
    for (int o = 1; o < 64; o <<= 1) { s0 += __shfl_xor(s0, o); s1 += __shfl_xor(s1, o); }
    const float r0 = rsqrtf(s0 * (1.f / DM) + EPS), r1 = rsqrtf(s1 * (1.f / DM) + EPS);
#pragma unroll
    for (int j = 0; j < 4; ++j) { const f32x4 wv = *(const f32x4*)(w + 4 * lane + 256 * j); v0[j] = v0[j] * r0 * wv; v1[j] = v1[j] * r1 * wv;
        u32x2 o; o.x = pk2(v0[j].x, v0[j].y); o.y = pk2(v0[j].z, v0[j].w); *(u32x2*)(orow0 + 4 * lane + 256 * j) = o;
        u32x2 p; p.x = pk2(v1[j].x, v1[j].y); p.y = pk2(v1[j].z, v1[j].w); *(u32x2*)(orow1 + 4 * lane + 256 * j) = p; }
    float g[32];
#pragma unroll
    for (int gi = 0; gi < 16; ++gi) { float a = 0.f, b = 0.f;
#pragma unroll
        for (int j = 0; j < 4; ++j) { const f32x4 ww = *(const LAS f32x4*)(wg + gi * 1024 + 4 * lane + 256 * j);
            a += (v0[j].x * ww.x + v0[j].y * ww.y) + (v0[j].z * ww.z + v0[j].w * ww.w); b += (v1[j].x * ww.x + v1[j].y * ww.y) + (v1[j].z * ww.z + v1[j].w * ww.w); }
        g[gi] = a; g[16 + gi] = b; }
#pragma unroll
    for (int i = 0; i < 16; ++i) { const bool up = lane & 1; const float send = up ? g[i] : g[i + 16], keep = up ? g[i + 16] : g[i]; g[i] = keep + __shfl_xor(send, 1); }
#pragma unroll
    for (int i = 0; i < 8; ++i) { const bool up = lane & 2; const float send = up ? g[i] : g[i + 8], keep = up ? g[i + 8] : g[i]; g[i] = keep + __shfl_xor(send, 2); }
#pragma unroll
    for (int i = 0; i < 4; ++i) { const bool up = lane & 4; const float send = up ? g[i] : g[i + 4], keep = up ? g[i + 4] : g[i]; g[i] = keep + __shfl_xor(send, 4); }
#pragma unroll
    for (int i = 0; i < 2; ++i) { const bool up = lane & 8; const float send = up ? g[i] : g[i + 2], keep = up ? g[i + 2] : g[i]; g[i] = keep + __shfl_xor(send, 8); }
    { const bool up = lane & 16; const float send = up ? g[0] : g[1], keep = up ? g[1] : g[0]; g[0] = keep + __shfl_xor(send, 16); }
    g[0] += __shfl_xor(g[0], 32);
    const int idx = ((lane & 1) << 4) | ((lane & 2) << 2) | (lane & 4) | ((lane & 8) >> 2) | ((lane & 16) >> 4);
    if (lane < 32) ((idx & 16) ? grow1 : grow0)[idx & 15] = g[0];
}
DI void transpose_matrix(const float* src, int ld, int K, int N, bf16_t* dst, LAS float* scr, int& cursor, int gw, int NGW, int lane, const float* ksc = nullptr) {
    const int nkb = K / 64, nnb = N / 32, items = nkb * nnb;
    int first = (gw - cursor % NGW + NGW) % NGW;
    for (int it = first; it < items; it += NGW) { const int kb = it / nnb, nb = it % nnb; transpose_item(src, ld, dst, K, scr, kb * 64, nb * 32, lane, ksc); }
    cursor += items;
}

DI void phase0(const Params& P, LAS unsigned char* lds) {
    const int tid = get_tid(), lane = tid & 63, wave = tid >> 6, gw = blockIdx.x * 8 + wave, NGW = gridDim.x * 8;
    LAS float* wg = (LAS float*)lds;
    LAS float* scr = (LAS float*)(lds + 65536 + wave * 8448);
    for (int i = tid; i < 16 * 1024; i += 512) { const int g = i >> 10, k = i & 1023; const int col = g < 8 ? 2048 + g : 4104 + (g - 8); wg[i] = P.w_in[(size_t)k * INC + col]; }
    __syncthreads();
    bf16_t* WS = (bf16_t*)P.ws;
    { float* q1 = (float*)(P.ws + W_SQ1); float* q2 = (float*)(P.ws + W_SQ2); for (int i = blockIdx.x * 512 + tid; i < NTOK; i += gridDim.x * 512) { q1[i] = 0.f; q2[i] = 0.f; } }
    { bf16_t* XN = (bf16_t*)(P.ws + W_XN); bf16_t* XBSp = (bf16_t*)(P.ws + W_XBS); float* GT = (float*)(P.ws + W_GATES);
      f32x4 v[4], v2[4], nv[4], nv2[4];
      load_row(v, P.x_prompt + (size_t)gw * DM, lane); load_row(v2, P.x_prompt + (size_t)(gw + NGW) * DM, lane);
      for (int r = gw; r < NTOK; r += 2 * NGW) { const int r2 = r + NGW, rn = r + 2 * NGW, rn2 = r + 3 * NGW;
          if (rn < NTOK) load_row(nv, rn < NP ? P.x_prompt + (size_t)rn * DM : P.x_sample + (size_t)(rn - NP) * DM, lane);
          if (rn2 < NTOK) load_row(nv2, rn2 < NP ? P.x_prompt + (size_t)rn2 * DM : P.x_sample + (size_t)(rn2 - NP) * DM, lane);
          bf16_t* o1 = r < NP ? XN + (size_t)r * DM : XBSp + (size_t)(r - NP) * DM; bf16_t* o2 = r2 < NP ? XN + (size_t)r2 * DM : XBSp + (size_t)(r2 - NP) * DM;
          if (r2 < NTOK) norm_row2_gates(v, v2, P.norm_mix_w, o1, o2, GT + (size_t)r * 16, GT + (size_t)r2 * 16, wg, lane);
          else norm_row<true>(v, P.norm_mix_w, o1, GT + (size_t)r * 16, wg, lane);
#pragma unroll
          for (int j = 0; j < 4; ++j) { v[j] = nv[j]; v2[j] = nv2[j]; } }
      bf16_t* MN = (bf16_t*)(P.ws + W_MN);
      load_row(v, P.mem_prompt + (size_t)gw * DM, lane);
      for (int r = gw; r < 4096; r += NGW) { const int rn = r + NGW;
          if (rn < 4096) load_row(nv, P.mem_prompt + (size_t)rn * DM, lane);
          norm_row<false>(v, P.norm_mem_w, MN + (size_t)r * DM, nullptr, wg, lane);
#pragma unroll
          for (int j = 0; j < 4; ++j) v[j] = nv[j]; } }
    int cur = 0;
    transpose_matrix(P.w_in, INC, DM, 2048, (bf16_t*)(P.ws + W_IN), scr, cur, gw, NGW, lane);
    transpose_matrix(P.w_in + 2056, INC, DM, 2048, (bf16_t*)(P.ws + W_IN) + (size_t)2048 * DM, scr, cur, gw, NGW, lane);
    transpose_matrix(P.wk, DM, DM, DM, (bf16_t*)(P.ws + W_K), scr, cur, gw, NGW, lane);
    transpose_matrix(P.wv, DM, DM, DM, (bf16_t*)(P.ws + W_V), scr, cur, gw, NGW, lane);
    (void)WS;
}

DI int swz72(int d, int t) { return d * 72 + ((((t >> 3) ^ (d >> 3)) & 7) << 3) + (t & 7); }
template <int K, bool SA, bool SB> DI f32x4 mm16s(const LAS bf16_t* A, int rowA0, const LAS bf16_t* B, int rowB0, f32x4 acc, int lane) {
    const int ra = rowA0 + (lane & 15), rb = rowB0 + (lane & 15), q = lane >> 4, ga = SA ? (ra >> 3) & 7 : 0, gb = SB ? (rb >> 3) & 7 : 0;
#pragma unroll
    for (int ks = 0; ks < K / 32; ++ks) {
        const bf16x8 a = *(const LAS bf16x8*)(A + ra * 72 + (((4 * ks + q) ^ ga) << 3)), b = *(const LAS bf16x8*)(B + rb * 72 + (((4 * ks + q) ^ gb) << 3));
        acc = __builtin_amdgcn_mfma_f32_16x16x32_bf16(a, b, acc, 0, 0, 0);
    }
    return acc;
}

DI void ldfr128(bf16x8 (&f)[4], const LAS bf16_t* base, int ld, int lane) {
    const LAS bf16_t* p = base + (lane & 15) * ld + (lane >> 4) * 8;
#pragma unroll
    for (int k = 0; k < 4; ++k) f[k] = *(const LAS bf16x8*)(p + 32 * k);
}
template <bool SW> DI void ldfr64(bf16x8 (&f)[2], const LAS bf16_t* img, int row0, int lane) {
    const int r = row0 + (lane & 15), q = lane >> 4, g = SW ? (r >> 3) & 7 : 0;
#pragma unroll
    for (int ks = 0; ks < 2; ++ks) f[ks] = *(const LAS bf16x8*)(img + r * 72 + (((4 * ks + q) ^ g) << 3));
}
DI f32x4 mma4(const bf16x8 (&a)[4], const bf16x8 (&b)[4], f32x4 acc) {
#pragma unroll
    for (int k = 0; k < 4; ++k) acc = __builtin_amdgcn_mfma_f32_16x16x32_bf16(a[k], b[k], acc, 0, 0, 0);
    return acc;
}
DI f32x4 mma2(const bf16x8 (&a)[2], const bf16x8 (&b)[2], f32x4 acc) {
#pragma unroll
    for (int k = 0; k < 2; ++k) acc = __builtin_amdgcn_mfma_f32_16x16x32_bf16(a[k], b[k], acc, 0, 0, 0);
    return acc;
}

DI void phase_conv(const Params& P, LAS unsigned char* lds, int row_lo, int nrows, unsigned gt, unsigned stride) {
    const int tid = get_tid();
    const bf16_t* PROJ = (const bf16_t*)(P.ws + W_PROJ); bf16_t* QC = (bf16_t*)(P.ws + W_QKVC);
    const float* cw = P.conv_w; const float* stc = P.st_conv;
    LAS float* cwl = (LAS float*)lds;
    for (int i = tid; i < 1536; i += 512) *(LAS f32x4*)(cwl + 4 * i) = *(const f32x4*)(cw + 4 * i);
    __syncthreads();
    const unsigned total = (unsigned)nrows * 192u;
    for (unsigned it0 = gt; it0 < total; it0 += 4u * stride) {
        u32x4 x4[4][4];
#pragma unroll
        for (int u = 0; u < 4; ++u) { const unsigned itu = it0 + u * stride, it = itu < total ? itu : it0;
            const int rrel = it / 192u, row = row_lo + rrel, cb = (it - rrel * 192u) * 8, tl = row < NP ? (row & (SEQ - 1)) : ((row - NP) & (TS - 1));
#pragma unroll
            for (int r = 0; r < 4; ++r) { const int back = 3 - r, rr = back <= tl ? row - back : row; x4[u][r] = *(const u32x4*)(PROJ + (size_t)rr * NMAIN + 2048 + cb); } }
#pragma unroll
        for (int u = 0; u < 4; ++u) { const unsigned it = it0 + u * stride;
            if (it < total) {
                const int rrel = it / 192u, row = row_lo + rrel, cg = it - rrel * 192u, cb = cg * 8, tl = row < NP ? (row & (SEQ - 1)) : ((row - NP) & (TS - 1));
                float y[8];
#pragma unroll
                for (int j = 0; j < 8; ++j) y[j] = 0.f;
#pragma unroll
                for (int r = 0; r < 4; ++r) { const LAS float* wp = cwl + r * 1536 + cb; const f32x4 w0 = *(const LAS f32x4*)wp, w1 = *(const LAS f32x4*)(wp + 4);
                    const float mk = (3 - r) <= tl ? 1.f : 0.f;
                    y[0] += mk * w0.x * bflo(x4[u][r][0]); y[1] += mk * w0.y * bfhi(x4[u][r][0]); y[2] += mk * w0.z * bflo(x4[u][r][1]); y[3] += mk * w0.w * bfhi(x4[u][r][1]);
                    y[4] += mk * w1.x * bflo(x4[u][r][2]); y[5] += mk * w1.y * bfhi(x4[u][r][2]); y[6] += mk * w1.z * bflo(x4[u][r][3]); y[7] += mk * w1.w * bfhi(x4[u][r][3]); }
                if (row >= NP && tl < 3) {
                    const int b = (row - NP) >> 4;
                    for (int r = 0; r < 3 - tl; ++r) { const int hist = tl + r;
                        const float* cp = stc + ((size_t)b * 3 + hist) * 1536 + cb; const float* wp = cw + r * 1536 + cb;
#pragma unroll
                        for (int j = 0; j < 8; ++j) y[j] += wp[j] * cp[j]; } }
#pragma unroll
                for (int j = 0; j < 8; ++j) y[j] = y[j] * sigmoidf_(y[j]);
                float ss = 0.f;
#pragma unroll
                for (int j = 0; j < 8; ++j) ss += y[j] * y[j];
                ss += __shfl_xor(ss, 1); ss += __shfl_xor(ss, 2); ss += __shfl_xor(ss, 4); ss += __shfl_xor(ss, 8);
                const float rn = cg < 128 ? rsqrtf(ss + EPS) : 1.f;
                u32x4 o; o.x = pk2(y[0] * rn, y[1] * rn); o.y = pk2(y[2] * rn, y[3] * rn); o.z = pk2(y[4] * rn, y[5] * rn); o.w = pk2(y[6] * rn, y[7] * rn);
                *(u32x4*)(QC + (size_t)row * 1536 + cb) = o; } }
    }
    __syncthreads();
}

DI void mlstm_seq(const Params& P, LAS unsigned char* lds, int b, int h, bool sample) {
    const int tid = get_tid(), lane = tid & 63, w = tid >> 6;
    LAS bf16_t* Qs = (LAS bf16_t*)(lds + 0);
    LAS bf16_t* Ks = (LAS bf16_t*)(lds + 17408);
    LAS bf16_t* Vt = (LAS bf16_t*)(lds + 34816);
    LAS bf16_t* Kwt = (LAS bf16_t*)(lds + 53248);
    LAS bf16_t* C0t = (LAS bf16_t*)(lds + 71680);
    LAS bf16_t* Sm = (LAS bf16_t*)(lds + 106496);
    LAS float* Hf = (LAS float*)(lds + 115712);
    LAS float* sm = (LAS float*)(lds + 149504);
    LAS float *sm_a = sm, *sm_bm = sm + 64, *sm_wi = sm + 128, *sm_ws = sm + 192, *sm_en = sm + 256, *sm_qn = sm + 320, *sm_rs = sm + 384  ,
              *sm_n0 = sm + 640  , *sm_np = sm + 768  , *sm_misc = sm + 1280, *sm_nw = sm + 1288  ;
    const bf16_t* PROJ = (const bf16_t*)(P.ws + W_PROJ); const float* GT = (const float*)(P.ws + W_GATES); bf16_t* HC = (bf16_t*)(P.ws + W_HCAT);
    const int row0 = sample ? NP + b * TS : b * SEQ, nchunks = sample ? 1 : 64, valid = sample ? TS : 64, bh = b * 4 + h;
    const float igb = P.ig_b[h], fgb = P.fg_b[h];
    const int lt = tid >> 4, lch = tid & 15;
    const int nt = tid >> 3, npart = tid & 7;
    f32x4 accs[8]; float m0 = 0.f;
    if (tid < 128) sm_nw[tid] = P.mlstm_norm_w[tid];
    if (sample) { const float* C0 = P.st_C + (size_t)bh * 16384;
#pragma unroll
        for (int j = 0; j < 8; ++j)
#pragma unroll
            for (int r = 0; r < 4; ++r) accs[j][r] = C0[(j * 16 + (lane >> 4) * 4 + r) * 128 + w * 16 + (lane & 15)];
        if (tid < 128) sm_n0[tid] = P.st_n[bh * 128 + tid];
        m0 = P.st_m[bh];
    } else {
#pragma unroll
        for (int j = 0; j < 8; ++j) accs[j] = (f32x4){0.f, 0.f, 0.f, 0.f};
        if (tid < 128) sm_n0[tid] = 0.f;
    }
#pragma unroll
    for (int j = 0; j < 8; ++j) *(LAS s16x4*)(C0t + (w * 16 + (lane & 15)) * 136 + j * 16 + (lane >> 4) * 4) = pack4(accs[j]);
    u32x4 nq[2], nk[2], nv[2], noa0, noa1; float ng0 = 0.f, ng1 = 0.f;
    const u32x4 Z4 = (u32x4){0u, 0u, 0u, 0u};
#define ML_ISSUE_QKV(cc) do { const int r0n_ = row0 + (cc) * 64; _Pragma("unroll") for (int e = 0; e < 2; ++e) { const int t = lt + 32 * e; nq[e] = Z4; nk[e] = Z4; nv[e] = Z4; \
        if (t < valid) { const bf16_t* pr = PROJ + (size_t)(r0n_ + t) * NMAIN + h * 128 + lch * 8; nq[e] = *(const u32x4*)pr; nk[e] = *(const u32x4*)(pr + 512); nv[e] = *(const u32x4*)(pr + 1024); } } \
        if (w == 0 && lane < valid) { const float* gr = GT + (size_t)(r0n_ + lane) * 16; ng0 = gr[h]; ng1 = gr[4 + h]; } } while (0)
#define ML_ISSUE_OA(cc) do { noa0 = Z4; noa1 = Z4; if (nt < valid) { const bf16_t* oa = PROJ + (size_t)(row0 + (cc) * 64 + nt) * NMAIN + 1536 + h * 128 + npart * 16; noa0 = *(const u32x4*)oa; noa1 = *(const u32x4*)(oa + 8); } } while (0)
    ML_ISSUE_QKV(0); ML_ISSUE_OA(0);
    lds_barrier();
    for (int c = 0; c < nchunks; ++c) {
        const int r0 = row0 + c * 64;
        if (w == 0) {
            const int t = lane; float ig = -INFINITY, lf = 0.f;
            if (t < valid) { ig = ng0 + igb; const float f = ng1 + fgb; lf = fminf(f, 0.f) - __logf(1.f + __expf(-fabsf(f))); }
            float bc = lf;
#pragma unroll
            for (int o = 1; o < 64; o <<= 1) { const float u = __shfl_up(bc, o); if (lane >= o) bc += u; }
            const float a = ig - bc; float pm = a;
#pragma unroll
            for (int o = 1; o < 64; o <<= 1) { const float u = __shfl_up(pm, o); if (lane >= o) pm = fmaxf(pm, u); }
            const float mt = bc + fmaxf(m0, pm);
            const float blast = __shfl(bc, 63), mlast = __shfl(mt, 63);
            sm_a[t] = a; sm_bm[t] = bc - mt; sm_wi[t] = __expf(bc + m0 - mt); sm_ws[t] = __expf(blast + a - mlast) * SCALE_H; sm_en[t] = __expf(-mt);
            if (lane == 0) { sm_misc[0] = __expf(blast + m0 - mlast); sm_misc[1] = mlast; }
        }
        lds_barrier();
#pragma unroll
        for (int e = 0; e < 2; ++e) { const int t = lt + 32 * e, ch = lch; const u32x4 q4 = nq[e], k4 = nk[e], v4 = nv[e];
            *(LAS u32x4*)(Qs + t * 136 + ch * 8) = q4; *(LAS u32x4*)(Ks + t * 136 + ch * 8) = k4;
            const float wsv = sm_ws[t];
#pragma unroll
            for (int j = 0; j < 4; ++j) { const unsigned ku = k4[j], vu = v4[j];
                Kwt[swz72(ch * 8 + 2 * j, t)] = f2bf(bflo(ku) * wsv); Kwt[swz72(ch * 8 + 2 * j + 1, t)] = f2bf(bfhi(ku) * wsv);
                Vt[swz72(ch * 8 + 2 * j, t)] = (bf16_t)(vu & 0xffffu); Vt[swz72(ch * 8 + 2 * j + 1, t)] = (bf16_t)(vu >> 16); } }
        if (c + 1 < nchunks) ML_ISSUE_QKV(c + 1);
        lds_barrier();
        { const int t = tid >> 3, part = tid & 7; float s = 0.f;
#pragma unroll
          for (int j = 0; j < 16; ++j) s += bf2f(Qs[t * 136 + part * 16 + j]) * sm_n0[part * 16 + j];
          s += __shfl_xor(s, 1); s += __shfl_xor(s, 2); s += __shfl_xor(s, 4);
          if (part == 0) sm_qn[t] = s; }
        { const int dk = tid & 127, pq = tid >> 7; float s = 0.f;
#pragma unroll
          for (int j = 0; j < 16; ++j) { const int ss = pq * 16 + j; s += sm_ws[ss] * bf2f(Ks[ss * 136 + dk]); }
          sm_np[pq * 128 + dk] = s; }
        const int ti = w >> 1;
        { bf16x8 aq[4]; ldfr128(aq, Qs + ti * 16 * 136, 136, lane);
        float bmr[4];
#pragma unroll
        for (int r = 0; r < 4; ++r) bmr[r] = sm_bm[ti * 16 + (lane >> 4) * 4 + r];
        f32x4 acc2[2]; float as2[2];
#pragma unroll
        for (int e = 0; e < 2; ++e) { const int si = (w * 2 + e) & 3; acc2[e] = (f32x4){0.f, 0.f, 0.f, 0.f}; as2[e] = sm_a[si * 16 + (lane & 15)];
            if (si <= ti) { bf16x8 bk[4]; ldfr128(bk, Ks + si * 16 * 136, 136, lane); acc2[e] = mma4(aq, bk, acc2[e]); } }
#pragma unroll
        for (int e = 0; e < 2; ++e) { const int si = (w * 2 + e) & 3; const f32x4 acc = acc2[e];
            const int s = si * 16 + (lane & 15); const float as = as2[e]; float rs[4];
#pragma unroll
            for (int r = 0; r < 4; ++r) { const int t = ti * 16 + (lane >> 4) * 4 + r; const float val = (s <= t) ? acc[r] * SCALE_H * __expf(bmr[r] + as) : 0.f; Sm[t * 72 + s] = f2bf(val); rs[r] = val; }
#pragma unroll
            for (int r = 0; r < 4; ++r) { rs[r] += __shfl_xor(rs[r], 1); rs[r] += __shfl_xor(rs[r], 2); rs[r] += __shfl_xor(rs[r], 4); rs[r] += __shfl_xor(rs[r], 8); }
            if ((lane & 15) == 0) {
#pragma unroll
                for (int r = 0; r < 4; ++r) sm_rs[si * 64 + ti * 16 + (lane >> 4) * 4 + r] = rs[r]; } } }
        lds_barrier();
        { bf16x8 aq[4]; ldfr128(aq, Qs + ti * 16 * 136, 136, lane); bf16x8 asc[2]; ldfr64<false>(asc, Sm, ti * 16, lane);
          float wir[4], invd[4];
#pragma unroll
          for (int r = 0; r < 4; ++r) { const int t = ti * 16 + (lane >> 4) * 4 + r; wir[r] = sm_wi[t];
              const float den = wir[r] * sm_qn[t] + ((sm_rs[t] + sm_rs[64 + t]) + (sm_rs[128 + t] + sm_rs[192 + t]));
              invd[r] = 1.f / fmaxf(fabsf(den), sm_en[t]); }
#pragma unroll 2
          for (int e = 0; e < 4; ++e) { const int di = (w & 1) * 4 + e;
              bf16x8 bc[4]; ldfr128(bc, C0t + di * 16 * 136, 136, lane);
              bf16x8 bv[2]; ldfr64<true>(bv, Vt, di * 16, lane);
              f32x4 acc = mma4(aq, bc, (f32x4){0.f, 0.f, 0.f, 0.f});
#pragma unroll
              for (int r = 0; r < 4; ++r) acc[r] *= wir[r];
              acc = mma2(asc, bv, acc);
#pragma unroll
              for (int r = 0; r < 4; ++r) Hf[(ti * 16 + (lane >> 4) * 4 + r) * 132 + di * 16 + (lane & 15)] = acc[r] * invd[r]; } }
        lds_barrier();
        { const int t = nt, part = npart; float hv[16]; float ss = 0.f;
#pragma unroll
          for (int j = 0; j < 4; ++j) { const f32x4 x = *(const LAS f32x4*)(Hf + t * 132 + part * 16 + 4 * j); hv[4 * j] = x.x; hv[4 * j + 1] = x.y; hv[4 * j + 2] = x.z; hv[4 * j + 3] = x.w; ss += (x.x * x.x + x.y * x.y) + (x.z * x.z + x.w * x.w); }
          ss += __shfl_xor(ss, 1); ss += __shfl_xor(ss, 2); ss += __shfl_xor(ss, 4);
          const float rs = rsqrtf(ss * (1.f / 128.f) + EPS);
          if (t < valid) { const u32x4 o0 = noa0, o1 = noa1; const LAS float* nw = sm_nw + part * 16; u32x4 r0v, r1v;
#pragma unroll
              for (int j = 0; j < 4; ++j) { const float a0 = hv[2 * j] * rs * nw[2 * j] * sigmoidf_(bflo(o0[j])), a1 = hv[2 * j + 1] * rs * nw[2 * j + 1] * sigmoidf_(bfhi(o0[j])); r0v[j] = pk2(a0, a1);
                  const float b0 = hv[8 + 2 * j] * rs * nw[8 + 2 * j] * sigmoidf_(bflo(o1[j])), b1 = hv[9 + 2 * j] * rs * nw[9 + 2 * j] * sigmoidf_(bfhi(o1[j])); r1v[j] = pk2(b0, b1); }
              bf16_t* op = HC + (size_t)(r0 + t) * DM + h * 128 + part * 16; *(u32x4*)op = r0v; *(u32x4*)(op + 8) = r1v; }
          if (c + 1 < nchunks) ML_ISSUE_OA(c + 1); }
        { const float d0 = sm_misc[0];
          bf16x8 bvw[2]; ldfr64<true>(bvw, Vt, w * 16, lane);
#pragma unroll
          for (int j = 0; j < 8; ++j) { accs[j] = accs[j] * d0; bf16x8 ak[2]; ldfr64<true>(ak, Kwt, j * 16, lane); accs[j] = mma2(ak, bvw, accs[j]); }
#pragma unroll
          for (int j = 0; j < 8; ++j) *(LAS s16x4*)(C0t + (w * 16 + (lane & 15)) * 136 + j * 16 + (lane >> 4) * 4) = pack4(accs[j]);
          if (tid < 128) sm_n0[tid] = d0 * sm_n0[tid] + ((sm_np[tid] + sm_np[128 + tid]) + (sm_np[256 + tid] + sm_np[384 + tid]));
          m0 = sm_misc[1]; }
        lds_barrier();
    }
#undef ML_ISSUE_QKV
#undef ML_ISSUE_OA
    { float* Co = P.out + (sample ? O_SC : O_PC) + (size_t)bh * 16384;
#pragma unroll
      for (int j = 0; j < 8; ++j)
#pragma unroll
          for (int r = 0; r < 4; ++r) Co[(j * 16 + (lane >> 4) * 4 + r) * 128 + w * 16 + (lane & 15)] = accs[j][r];
      if (tid < 128) P.out[(sample ? O_SN : O_PN) + bh * 128 + tid] = sm_n0[tid];
      if (tid == 0) P.out[(sample ? O_SM : O_PM) + bh] = m0; }
    lds_barrier();
}

DI void gdn_s2(const LAS bf16_t* __restrict__ Qs, const LAS bf16_t* __restrict__ Ks, LAS bf16_t* __restrict__ Am, LAS bf16_t* __restrict__ QKd, LAS float* __restrict__ Adg,
               const LAS float* __restrict__ sm_G, const LAS float* __restrict__ sm_beta, int w, int lane) {
    const int kind = w >> 2, ti = w & 3; bf16x8 afr[4]; ldfr128(afr, (kind ? Qs : Ks) + ti * 16 * 136, 136, lane);
    float Gt[4], bt[4];
#pragma unroll
    for (int r = 0; r < 4; ++r) { const int t = ti * 16 + (lane >> 4) * 4 + r; Gt[r] = sm_G[t]; bt[r] = sm_beta[t]; }
#pragma unroll 2
    for (int si = 0; si < 4; ++si) { f32x4 acc = (f32x4){0.f, 0.f, 0.f, 0.f};
        if (si <= ti) { bf16x8 bk[4]; ldfr128(bk, Ks + si * 16 * 136, 136, lane); acc = mma4(afr, bk, acc); }
        const int s = si * 16 + (lane & 15); const float Gs = sm_G[s];
#pragma unroll
        for (int r = 0; r < 4; ++r) { const int t = ti * 16 + (lane >> 4) * 4 + r; const float dec = (s <= t) ? __expf(Gt[r] - Gs) : 0.f;
            if (kind == 0) { const float val = (s < t) ? bt[r] * dec * acc[r] : 0.f;
                if (ti == si) { Adg[ti * 320 + (t & 15) * 20 + (s & 15)] = val; Am[t * 72 + s] = 0; } else Am[t * 72 + s] = f2bf(val); }
            else QKd[t * 72 + s] = f2bf(SCALE_H * dec * acc[r]); } }
}

DI void gdn_seq(const Params& P, LAS unsigned char* lds, int b, int h, bool sample) {
    const int tid = get_tid(), lane = tid & 63, w = tid >> 6;
    LAS bf16_t* Qs = (LAS bf16_t*)(lds + 0);
    LAS bf16_t* Ks = (LAS bf16_t*)(lds + 17408);
    LAS bf16_t* Kdt = (LAS bf16_t*)(lds + 35840);
    LAS bf16_t* S0t = (LAS bf16_t*)(lds + 54272);
    LAS bf16_t* QKd = (LAS bf16_t*)(lds + 89088);
    LAS bf16_t* Am = (LAS bf16_t*)(lds + 98304);
    LAS bf16_t* Db = (LAS bf16_t*)(lds + 107520);
    LAS float* Adg = (LAS float*)(lds + 111872);
    LAS float* Rf = (LAS float*)(lds + 116992);
    LAS float* sm = (LAS float*)(lds + 150784);
    LAS float *sm_G = sm, *sm_gam = sm + 64, *sm_beta = sm + 128, *sm_bg = sm + 192, *sm_kd = sm + 256, *sm_misc = sm + 320, *sm_nw = sm + 328  ;
    const bf16_t* PROJ = (const bf16_t*)(P.ws + W_PROJ); const bf16_t* QC = (const bf16_t*)(P.ws + W_QKVC); const float* GT = (const float*)(P.ws + W_GATES); bf16_t* HC = (bf16_t*)(P.ws + W_HCAT);
    const int row0 = sample ? NP + b * TS : b * SEQ, nchunks = sample ? 1 : 64, valid = sample ? TS : 64, bh = b * 4 + h;
    const float Aexp = expf(P.A_log[h]), dtb = P.dt_bias[h];
    const int lt = tid >> 4, lch = tid & 15, nt = tid >> 3, npart = tid & 7;
    f32x4 accs[8];
    if (tid < 128) sm_nw[tid] = P.gdn_norm_w[tid];
    if (sample) { const float* S0 = P.st_S + (size_t)bh * 16384;
#pragma unroll
        for (int j = 0; j < 8; ++j)
#pragma unroll
            for (int r = 0; r < 4; ++r) accs[j][r] = S0[(j * 16 + (lane >> 4) * 4 + r) * 128 + w * 16 + (lane & 15)];
    } else {
#pragma unroll
        for (int j = 0; j < 8; ++j) accs[j] = (f32x4){0.f, 0.f, 0.f, 0.f};
    }
#pragma unroll
    for (int j = 0; j < 8; ++j) *(LAS s16x4*)(S0t + (w * 16 + (lane & 15)) * 136 + j * 16 + (lane >> 4) * 4) = pack4(accs[j]);
    u32x4 nq[2], nk[2], nv[2], nz0, nz1; float ng0 = 0.f, ng1 = 0.f;
    const u32x4 Z4 = (u32x4){0u, 0u, 0u, 0u};
#define GD_ISSUE_QKV(cc) do { const int r0n_ = row0 + (cc) * 64; _Pragma("unroll") for (int e = 0; e < 2; ++e) { const int t = lt + 32 * e; nq[e] = Z4; nk[e] = Z4; nv[e] = Z4; \
        if (t < valid) { const bf16_t* pr = QC + (size_t)(r0n_ + t) * 1536 + h * 128 + lch * 8; nq[e] = *(const u32x4*)pr; nk[e] = *(const u32x4*)(pr + 512); nv[e] = *(const u32x4*)(pr + 1024); } } \
        if (w == 0 && lane < valid) { const float* gr = GT + (size_t)(r0n_ + lane) * 16; ng0 = gr[8 + h]; ng1 = gr[12 + h]; } } while (0)
#define GD_ISSUE_Z(cc) do { nz0 = Z4; nz1 = Z4; if (nt < valid) { const bf16_t* zp = PROJ + (size_t)(row0 + (cc) * 64 + nt) * NMAIN + 3584 + h * 128 + npart * 16; nz0 = *(const u32x4*)zp; nz1 = *(const u32x4*)(zp + 8); } } while (0)
    GD_ISSUE_QKV(0); GD_ISSUE_Z(0);
    lds_barrier();
    for (int c = 0; c < nchunks; ++c) {
        const int r0 = row0 + c * 64;
        if (w == 0) { const int t = lane; float g = 0.f, beta = 0.f;
            if (t < valid) { const float ab = ng0 + dtb; const float sp = fmaxf(ab, 0.f) + __logf(1.f + __expf(-fabsf(ab))); g = -Aexp * sp; beta = 1.f / (1.f + __expf(-ng1)); }
            float G = g;
#pragma unroll
            for (int o = 1; o < 64; o <<= 1) { const float u = __shfl_up(G, o); if (lane >= o) G += u; }
            const float Gl = __shfl(G, 63); const float eg = __expf(G);
            sm_G[t] = G; sm_gam[t] = eg; sm_beta[t] = beta; sm_bg[t] = beta * eg; sm_kd[t] = __expf(Gl - G);
            if (lane == 0) sm_misc[0] = __expf(Gl); }
        lds_barrier();
#pragma unroll
        for (int e = 0; e < 2; ++e) { const int t = lt + 32 * e, ch = lch; const u32x4 q4 = nq[e], k4 = nk[e], v4 = nv[e];
            *(LAS u32x4*)(Qs + t * 136 + ch * 8) = q4; *(LAS u32x4*)(Ks + t * 136 + ch * 8) = k4;
            const float kd = sm_kd[t], bt = sm_beta[t];
#pragma unroll
            for (int j = 0; j < 4; ++j) { const unsigned ku = k4[j];
                Kdt[swz72(ch * 8 + 2 * j, t)] = f2bf(bflo(ku) * kd); Kdt[swz72(ch * 8 + 2 * j + 1, t)] = f2bf(bfhi(ku) * kd); }
            f32x4 v0, v1; v0.x = bt * bflo(v4[0]); v0.y = bt * bfhi(v4[0]); v0.z = bt * bflo(v4[1]); v0.w = bt * bfhi(v4[1]); v1.x = bt * bflo(v4[2]); v1.y = bt * bfhi(v4[2]); v1.z = bt * bflo(v4[3]); v1.w = bt * bfhi(v4[3]);
            *(LAS f32x4*)(Rf + t * 132 + ch * 8) = v0; *(LAS f32x4*)(Rf + t * 132 + ch * 8 + 4) = v1; }
        if (c + 1 < nchunks) GD_ISSUE_QKV(c + 1);
        lds_barrier();
        gdn_s2(Qs, Ks, Am, QKd, Adg, sm_G, sm_beta, w, lane);
        lds_barrier();
        if (w == 0) { const int blk = lane >> 4, cc = lane & 15; const LAS float* Ab = Adg + blk * 320; float X[16];
#pragma unroll
            for (int r = 0; r < 16; ++r) { float s = (cc == r) ? 1.f : 0.f;
#pragma unroll
                for (int q4 = 0; q4 < (r + 3) / 4; ++q4) { const f32x4 av = *(const LAS f32x4*)(Ab + r * 20 + 4 * q4);
                    if (4 * q4 + 0 < r) s -= av.x * X[4 * q4 + 0];
                    if (4 * q4 + 1 < r) s -= av.y * X[4 * q4 + 1];
                    if (4 * q4 + 2 < r) s -= av.z * X[4 * q4 + 2];
                    if (4 * q4 + 3 < r) s -= av.w * X[4 * q4 + 3]; }
                X[r] = s; }
#pragma unroll
            for (int r = 0; r < 16; ++r) Db[blk * 384 + r * 24 + cc] = f2bf(X[r]); }
        f32x4 rhs[4]; bf16x8 bs[4]; ldfr128(bs, S0t + w * 16 * 136, 136, lane);
#pragma unroll
        for (int si = 0; si < 4; ++si) { bf16x8 ak[4]; ldfr128(ak, Ks + si * 16 * 136, 136, lane); const f32x4 acc = mma4(ak, bs, (f32x4){0.f, 0.f, 0.f, 0.f});
#pragma unroll
            for (int r = 0; r < 4; ++r) { const int sr = si * 16 + (lane >> 4) * 4 + r; rhs[si][r] = Rf[sr * 132 + w * 16 + (lane & 15)] - sm_bg[sr] * acc[r]; } }
        lds_barrier();
        s16x4 Wb[4];
#pragma unroll
        for (int i = 0; i < 4; ++i) { f32x4 pacc = (f32x4){0.f, 0.f, 0.f, 0.f};
#pragma unroll
            for (int j = 0; j < i; ++j) { const s16x4 af = *(const LAS s16x4*)(Am + (i * 16 + (lane & 15)) * 72 + j * 16 + (lane >> 4) * 4);
                pacc = __builtin_amdgcn_mfma_f32_16x16x16bf16_1k(af, Wb[j], pacc, 0, 0, 0); }
            const f32x4 rr = rhs[i] - pacc;
            const s16x4 df = *(const LAS s16x4*)(Db + i * 384 + (lane & 15) * 24 + (lane >> 4) * 4);
            const f32x4 wi = __builtin_amdgcn_mfma_f32_16x16x16bf16_1k(df, pack4(rr), (f32x4){0.f, 0.f, 0.f, 0.f}, 0, 0, 0);
            Wb[i] = pack4(wi); }
#pragma unroll
        for (int tp = 0; tp < 2; ++tp) { f32x4 ov[2]; float gv[2][4];
#pragma unroll
            for (int h2 = 0; h2 < 2; ++h2) { const int ti = 2 * tp + h2;
#pragma unroll
                for (int r = 0; r < 4; ++r) gv[h2][r] = sm_gam[ti * 16 + (lane >> 4) * 4 + r];
                bf16x8 aq[4]; ldfr128(aq, Qs + ti * 16 * 136, 136, lane); ov[h2] = mma4(aq, bs, (f32x4){0.f, 0.f, 0.f, 0.f}); }
#pragma unroll
            for (int h2 = 0; h2 < 2; ++h2) { const int ti = 2 * tp + h2;
#pragma unroll
                for (int r = 0; r < 4; ++r) ov[h2][r] *= SCALE_H * gv[h2][r];
#pragma unroll
                for (int j = 0; j <= ti; ++j) { const s16x4 af = *(const LAS s16x4*)(QKd + (ti * 16 + (lane & 15)) * 72 + j * 16 + (lane >> 4) * 4);
                    ov[h2] = __builtin_amdgcn_mfma_f32_16x16x16bf16_1k(af, Wb[j], ov[h2], 0, 0, 0); } }
#pragma unroll
            for (int h2 = 0; h2 < 2; ++h2) { const int ti = 2 * tp + h2;
#pragma unroll
                for (int r = 0; r < 4; ++r) Rf[(ti * 16 + (lane >> 4) * 4 + r) * 132 + w * 16 + (lane & 15)] = ov[h2][r]; } }
        { const float dG = sm_misc[0];
#pragma unroll
          for (int j = 0; j < 8; ++j) { accs[j] = accs[j] * dG; const int dk = j * 16 + (lane & 15), gsw = (dk >> 3) & 7;
#pragma unroll
              for (int i = 0; i < 4; ++i) { const s16x4 kf = *(const LAS s16x4*)(Kdt + dk * 72 + ((((2 * i + (lane >> 5)) ^ gsw) & 7) << 3) + ((lane >> 4) & 1) * 4);
                  accs[j] = __builtin_amdgcn_mfma_f32_16x16x16bf16_1k(kf, Wb[i], accs[j], 0, 0, 0); } } }
        lds_barrier();
        {
#pragma unroll
          for (int j = 0; j < 8; ++j) *(LAS s16x4*)(S0t + (w * 16 + (lane & 15)) * 136 + j * 16 + (lane >> 4) * 4) = pack4(accs[j]); }
        { const int t = nt, part = npart; float hv[16]; float ss = 0.f;
#pragma unroll
          for (int j = 0; j < 4; ++j) { const f32x4 x = *(const LAS f32x4*)(Rf + t * 132 + part * 16 + 4 * j); hv[4 * j] = x.x; hv[4 * j + 1] = x.y; hv[4 * j + 2] = x.z; hv[4 * j + 3] = x.w; ss += (x.x * x.x + x.y * x.y) + (x.z * x.z + x.w * x.w); }
          ss += __shfl_xor(ss, 1); ss += __shfl_xor(ss, 2); ss += __shfl_xor(ss, 4);
          const float rs = rsqrtf(ss * (1.f / 128.f) + EPS);
          if (t < valid) { const u32x4 o0 = nz0, o1 = nz1; const LAS float* nw = sm_nw + part * 16; u32x4 r0v, r1v;
#pragma unroll
              for (int j = 0; j < 4; ++j) { const float z0 = bflo(o0[j]), z1 = bfhi(o0[j]), z2 = bflo(o1[j]), z3 = bfhi(o1[j]);
                  const float a0 = hv[2 * j] * rs * nw[2 * j] * z0 * sigmoidf_(z0), a1 = hv[2 * j + 1] * rs * nw[2 * j + 1] * z1 * sigmoidf_(z1); r0v[j] = pk2(a0, a1);
                  const float b0 = hv[8 + 2 * j] * rs * nw[8 + 2 * j] * z2 * sigmoidf_(z2), b1 = hv[9 + 2 * j] * rs * nw[9 + 2 * j] * z3 * sigmoidf_(z3); r1v[j] = pk2(b0, b1); }
              bf16_t* op = HC + (size_t)(r0 + t) * DM + 512 + h * 128 + part * 16; *(u32x4*)op = r0v; *(u32x4*)(op + 8) = r1v; }
          if (c + 1 < nchunks) GD_ISSUE_Z(c + 1); }
        lds_barrier();
    }
#undef GD_ISSUE_QKV
#undef GD_ISSUE_Z
    { float* So = P.out + (sample ? O_SS : O_PS) + (size_t)bh * 16384;
#pragma unroll
      for (int j = 0; j < 8; ++j)
#pragma unroll
          for (int r = 0; r < 4; ++r) So[(j * 16 + (lane >> 4) * 4 + r) * 128 + w * 16 + (lane & 15)] = accs[j][r];
      const int rl = sample ? row0 + TS - 3 : row0 + SEQ - 3; float* co = P.out + (sample ? O_SCONV : O_PCONV) + (size_t)b * 3 * 1536;
      for (int i = tid; i < 3 * 384; i += 512) { const int j = i / 384, q = i % 384, which = q >> 7, d = q & 127, cb = which * 512 + h * 128 + d;
          co[j * 1536 + cb] = bf2f(PROJ[(size_t)(rl + j) * NMAIN + 2048 + cb]); } }
    lds_barrier();
}

DI void phase2(const Params& P, LAS unsigned char* lds, int skipkind) {
    const int wg = blockIdx.x, G = gridDim.x;
    { const int nit = wg < 128 ? 1 : 2;
      for (int k = 0; k < nit; ++k) { const bool sample = wg >= 128; const int s_ = wg - 128 + 128 * k;
          const int kind = sample ? (s_ >= 128) : (wg >= 64); const int loc = sample ? (s_ & 127) : (wg & 63);
          if (kind == skipkind) continue;
          if (kind == 0) mlstm_seq(P, lds, loc >> 2, loc & 3, sample); else gdn_seq(P, lds, loc >> 2, loc & 3, sample); } }
    if (wg >= 128 || G <= 128) { const int nw = G > 128 ? G - 128 : G, me = G > 128 ? wg - 128 : wg, tid = get_tid(), lane = tid & 63, wave = tid >> 6;
        const float* mk = P.out + O_PMK; const float* mv = P.out + O_PMV; bf16_t* KB = (bf16_t*)(P.ws + W_KBP); bf16_t* VT = (bf16_t*)(P.ws + W_VTP);
        const size_t n8 = (size_t)4096 * 1024 / 8;
        for (size_t i = (size_t)me * 512 + tid; i < n8; i += (size_t)nw * 512) { const f32x4 a = *(const f32x4*)(mk + i * 8), b = *(const f32x4*)(mk + i * 8 + 4);
            u32x4 o; o.x = pk2(a.x, a.y); o.y = pk2(a.z, a.w); o.z = pk2(b.x, b.y); o.w = pk2(b.z, b.w); *(u32x4*)(KB + i * 8) = o; }
        LAS float* scr = (LAS float*)(lds + wave * 8448);
        for (int it = me * 8 + wave; it < 64 * 32; it += nw * 8) { const int bh = it >> 5, sub = it & 31, b = bh >> 2, h = bh & 3, kb = sub >> 3, nb = sub & 7;
            transpose_item(mv + (size_t)b * 256 * 1024 + h * 256, 1024, VT + (size_t)bh * 65536, 256, scr, kb * 64, nb * 32, lane); }
        { const int gw2 = me * 8 + wave, NGW2 = nw * 8; int cur = 0;
          transpose_matrix(P.w_out, DM, DM, DM, (bf16_t*)(P.ws + W_OUT), scr, cur, gw2, NGW2, lane);
          transpose_matrix(P.wq, DM, DM, DM, (bf16_t*)(P.ws + W_Q), scr, cur, gw2, NGW2, lane, P.norm_x_w);
          transpose_matrix(P.wo, DM, DM, DM, (bf16_t*)(P.ws + W_O), scr, cur, gw2, NGW2, lane);
          transpose_matrix(P.w1, DFF, DM, DFF, (bf16_t*)(P.ws + W_1), scr, cur, gw2, NGW2, lane, P.norm_ffn_w);
          transpose_matrix(P.w2, DM, DFF, DM, (bf16_t*)(P.ws + W_2), scr, cur, gw2, NGW2, lane);
          bf16_t* VTs = (bf16_t*)(P.ws + W_VTS);
          for (int it = gw2; it < 128 * 32; it += NGW2) { const int bh = it >> 5, sub = it & 31, b = bh >> 2, h = bh & 3, kb = sub >> 3, nb = sub & 7;
              transpose_item(P.cache_v + (size_t)b * 256 * 1024 + h * 256, 1024, VTs + (size_t)bh * 65536, 256, scr, kb * 64, nb * 32, lane); }
          bf16_t* KBs = (bf16_t*)(P.ws + W_KBS); const size_t n8s = (size_t)32 * 256 * 1024 / 8; const float* ck = P.cache_k;
          for (size_t i = (size_t)me * 512 + tid; i < n8s; i += (size_t)nw * 512) { const f32x4 a = *(const f32x4*)(ck + i * 8), b = *(const f32x4*)(ck + i * 8 + 4);
              u32x4 o; o.x = pk2(a.x, a.y); o.y = pk2(a.z, a.w); o.z = pk2(b.x, b.y); o.w = pk2(b.z, b.w); *(u32x4*)(KBs + i * 8) = o; } }
    }
}

DI void phase_attn(const Params& P, LAS unsigned char* lds, int item_lo, int item_hi, int me, int nwg) {
    const int tid = get_tid(), lane = tid & 63, w = tid >> 6, q = lane >> 4, c = lane & 15;
    const bf16_t* QB = (const bf16_t*)(P.ws + W_PROJ);
    const bf16_t* QSb = (const bf16_t*)(P.ws + W_QS);
    bf16_t* ATT = (bf16_t*)(P.ws + W_HCAT);
    const int lr = tid >> 5, lc = (tid & 31) * 8;
    for (int item = item_lo + me; item < item_hi; item += nwg) {
        int b, h, r0, valid; const bf16_t *KB, *VT, *Qrow;
        if (item < 2048) { const int bh = item >> 5, tile = item & 31; b = bh >> 2; h = bh & 3; r0 = b * SEQ + tile * 128; valid = 128;
            KB = (const bf16_t*)(P.ws + W_KBP) + (size_t)b * 256 * 1024; VT = (const bf16_t*)(P.ws + W_VTP) + (size_t)bh * 65536; Qrow = QB + (size_t)r0 * DM; }
        else { const int bh = item - 2048; b = bh >> 2; h = bh & 3; r0 = NP + b * TS; valid = TS;
            KB = (const bf16_t*)(P.ws + W_KBS) + (size_t)b * 256 * 1024; VT = (const bf16_t*)(P.ws + W_VTS) + (size_t)bh * 65536; Qrow = QSb + (size_t)(b * TS) * DM; }
        const int t = w * 16 + c; const bool tv = t < valid;
        bf16x8 qf[8];
#pragma unroll
        for (int k8 = 0; k8 < 8; ++k8) { u32x4 x = (u32x4){0u, 0u, 0u, 0u}; if (tv) x = *(const u32x4*)(Qrow + (size_t)t * DM + h * 256 + k8 * 32 + q * 8); qf[k8] = __builtin_bit_cast(bf16x8, x); }
        u32x4 ra[4], rb[4];
#define AT_LOAD(ra, p) do { if ((p) < 4) { _Pragma("unroll") for (int e = 0; e < 4; ++e) ra[e] = *(const u32x4*)(KB + (size_t)((p) * 64 + lr + 16 * e) * 1024 + h * 256 + lc); } \
                        else { _Pragma("unroll") for (int e = 0; e < 4; ++e) ra[e] = *(const u32x4*)(VT + (size_t)(((p) - 4) * 64 + lr + 16 * e) * 256 + lc); } } while (0)
#define AT_PUT(ra, p) do { LAS bf16_t* dst_ = (LAS bf16_t*)(lds + ((p) & 1) * 33792); _Pragma("unroll") for (int e = 0; e < 4; ++e) *(LAS u32x4*)(dst_ + (lr + 16 * e) * 264 + lc) = ra[e]; } while (0)
        AT_LOAD(ra, 0); AT_LOAD(rb, 1); AT_PUT(ra, 0); AT_LOAD(ra, 2);
        lds_barrier();
        f32x4 sacc[16];
#pragma unroll
        for (int p = 0; p < 4; ++p) {
            if (p & 1) { AT_PUT(ra, p + 1); AT_LOAD(ra, p + 3); } else { AT_PUT(rb, p + 1); AT_LOAD(rb, p + 3); }
            const LAS bf16_t* buf = (const LAS bf16_t*)(lds + (p & 1) * 33792);
#pragma unroll
            for (int nt = 0; nt < 4; ++nt) { const LAS bf16_t* kp = buf + (nt * 16 + c) * 264 + q * 8; f32x4 acc = (f32x4){0.f, 0.f, 0.f, 0.f};
#pragma unroll
                for (int k8 = 0; k8 < 8; ++k8) acc = __builtin_amdgcn_mfma_f32_16x16x32_bf16(*(const LAS bf16x8*)(kp + k8 * 32), qf[k8], acc, 0, 0, 0);
                sacc[p * 4 + nt] = acc; }
            lds_barrier();
        }
        float mx = -INFINITY;
#pragma unroll
        for (int i = 0; i < 16; ++i) mx = fmaxf(mx, fmaxf(fmaxf(sacc[i][0], sacc[i][1]), fmaxf(sacc[i][2], sacc[i][3])));
        mx = fmaxf(mx, __shfl_xor(mx, 16)); mx = fmaxf(mx, __shfl_xor(mx, 32));
        float sum = 0.f;
#pragma unroll
        for (int i = 0; i < 16; ++i)
#pragma unroll
            for (int r = 0; r < 4; ++r) { const float e = __expf((sacc[i][r] - mx) * 0.0625f); sacc[i][r] = e; sum += e; }
        sum += __shfl_xor(sum, 16); sum += __shfl_xor(sum, 32);
        const float inv = 1.f / sum;
        bf16x8 pf[8];
#pragma unroll
        for (int j = 0; j < 8; ++j) { const s16x4 lo = pack4(sacc[2 * j] * inv), hi = pack4(sacc[2 * j + 1] * inv);
            pf[j] = (bf16x8){lo[0], lo[1], lo[2], lo[3], hi[0], hi[1], hi[2], hi[3]}; }
#pragma unroll
        for (int p = 4; p < 8; ++p) {
            if (p + 1 < 8) { if (p & 1) { AT_PUT(ra, p + 1); } else { AT_PUT(rb, p + 1); } }
            if (p + 3 < 8) { if (p & 1) { AT_LOAD(ra, p + 3); } else { AT_LOAD(rb, p + 3); } }
            const LAS bf16_t* buf = (const LAS bf16_t*)(lds + (p & 1) * 33792);
#pragma unroll
            for (int dt = 0; dt < 4; ++dt) { const LAS bf16_t* vp = buf + (dt * 16 + c) * 264 + q * 4; f32x4 acc = (f32x4){0.f, 0.f, 0.f, 0.f};
#pragma unroll
                for (int j = 0; j < 8; ++j) { const s16x4 lo = *(const LAS s16x4*)(vp + 32 * j), hi = *(const LAS s16x4*)(vp + 32 * j + 16);
                    const bf16x8 vf = (bf16x8){lo[0], lo[1], lo[2], lo[3], hi[0], hi[1], hi[2], hi[3]};
                    acc = __builtin_amdgcn_mfma_f32_16x16x32_bf16(vf, pf[j], acc, 0, 0, 0); }
                if (tv) *(s16x4*)(ATT + (size_t)(r0 + t) * DM + h * 256 + (p - 4) * 64 + dt * 16 + q * 4) = pack4(acc); }
            lds_barrier();
        }
#undef AT_LOAD
#undef AT_PUT
    }
}

DI void phase_norm(const Params& P, const float* w) {
    const int tid = get_tid(), lane = tid & 63, gw = blockIdx.x * 8 + (tid >> 6), NGW = gridDim.x * 8;
    bf16_t* XN = (bf16_t*)(P.ws + W_XN);
    f32x4 v[4], nv[4];
    load_row(v, P.out + (size_t)gw * DM, lane);
    for (int r = gw; r < NTOK; r += NGW) { const int rn = r + NGW;
        if (rn < NTOK) load_row(nv, P.out + (size_t)rn * DM, lane);
        norm_row<false>(v, w, XN + (size_t)r * DM, nullptr, nullptr, lane);
#pragma unroll
        for (int j = 0; j < 4; ++j) v[j] = nv[j]; }
}
DI void phase_final(const Params& P, const bf16_t* xb, float* y, int nrows, int gw, int NGW) {
    const int tid = get_tid(), lane = tid & 63;
    u32x4 v[2], nv[2];
    if (gw < nrows) { v[0] = *(const u32x4*)(xb + (size_t)gw * DM + 8 * lane); v[1] = *(const u32x4*)(xb + (size_t)gw * DM + 512 + 8 * lane); }
    f32x4 wv[4];
#pragma unroll
    for (int j = 0; j < 2; ++j) { wv[2 * j] = *(const f32x4*)(P.norm_final_w + 512 * j + 8 * lane); wv[2 * j + 1] = *(const f32x4*)(P.norm_final_w + 512 * j + 8 * lane + 4); }
    for (int r = gw; r < nrows; r += NGW) { const int rn = r + NGW;
        if (rn < nrows) { nv[0] = *(const u32x4*)(xb + (size_t)rn * DM + 8 * lane); nv[1] = *(const u32x4*)(xb + (size_t)rn * DM + 512 + 8 * lane); }
        f32x4 x[4]; float s = 0.f;
#pragma unroll
        for (int j = 0; j < 2; ++j) { x[2 * j] = (f32x4){bflo(v[j].x), bfhi(v[j].x), bflo(v[j].y), bfhi(v[j].y)}; x[2 * j + 1] = (f32x4){bflo(v[j].z), bfhi(v[j].z), bflo(v[j].w), bfhi(v[j].w)}; }
#pragma unroll
        for (int j = 0; j < 4; ++j) s += (x[j].x * x[j].x + x[j].y * x[j].y) + (x[j].z * x[j].z + x[j].w * x[j].w);
        const float rstd = rsqrtf(wave_sum(s) * (1.f / DM) + EPS);
        float* yr = y + (size_t)r * DM;
#pragma unroll
        for (int j = 0; j < 2; ++j) { *(f32x4*)(yr + 512 * j + 8 * lane) = x[2 * j] * rstd * wv[2 * j]; *(f32x4*)(yr + 512 * j + 8 * lane + 4) = x[2 * j + 1] * rstd * wv[2 * j + 1]; }
        v[0] = nv[0]; v[1] = nv[1]; }
}

DI void tree_barrier(unsigned* ctl, unsigned k, unsigned idx = 0xffffffffu, unsigned ngroups = 8u) {
    __builtin_amdgcn_fence(__ATOMIC_RELEASE, "workgroup");
    __builtin_amdgcn_s_barrier();
    if (threadIdx.x == 0) {
        __builtin_amdgcn_fence(__ATOMIC_ACQUIRE, "workgroup");
        __builtin_amdgcn_fence(__ATOMIC_RELEASE, "agent");
        if (idx == 0xffffffffu) idx = blockIdx.x;
        unsigned* grp = ctl + 64 * (idx % ngroups); unsigned* glob = ctl + 64 * 8; unsigned* gen = ctl + 64 * 9;
        const unsigned old = __hip_atomic_fetch_add(grp, 1u, __ATOMIC_RELAXED, __HIP_MEMORY_SCOPE_AGENT);
        if (old == 32u * k - 1u) { const unsigned old2 = __hip_atomic_fetch_add(glob, 1u, __ATOMIC_RELAXED, __HIP_MEMORY_SCOPE_AGENT);
            if (old2 == ngroups * k - 1u) __hip_atomic_store(gen, k, __ATOMIC_RELAXED, __HIP_MEMORY_SCOPE_AGENT); }
        unsigned polls = 0;
        while (__hip_atomic_load(gen, __ATOMIC_RELAXED, __HIP_MEMORY_SCOPE_AGENT) < k) { __builtin_amdgcn_s_sleep(1); if (++polls > 4000000u) break; }
        __builtin_amdgcn_fence(__ATOMIC_ACQUIRE, "agent");
        __builtin_amdgcn_fence(__ATOMIC_RELEASE, "workgroup");
    }
    __builtin_amdgcn_s_barrier();
    __builtin_amdgcn_fence(__ATOMIC_ACQUIRE, "workgroup");
}

DI void rstd_pass(const float* sq, float* rstd, int lo, int hi, int gt, int NT) {
    for (int r = lo + gt; r < hi; r += NT) { const f32x4* sp = (const f32x4*)(sq + (size_t)r * 16); const f32x4 a = sp[0], b = sp[1], c = sp[2], d = sp[3];
        const float tot = (((a.x + a.y) + (a.z + a.w)) + ((b.x + b.y) + (b.z + b.w))) + (((c.x + c.y) + (c.z + c.w)) + ((d.x + d.y) + (d.z + d.w)));
        rstd[r] = rsqrtf(tot * (1.f / DM) + EPS); }
}
DI void sample_pre(const Params& P, LAS unsigned char* lds, unsigned* ctl2, unsigned& k2) {
    const int me = blockIdx.x - 128; unsigned char* ws = P.ws; float* out = P.out;
    { EpiBf16<0, false> e; e.O = (bf16_t*)(ws + W_PROJ) + (size_t)NP * NMAIN; e.ldc = NMAIN; e.rstd = nullptr; run_gemm(lds, (const bf16_t*)(ws + W_XBS), (const bf16_t*)(ws + W_IN), NS, NMAIN, DM, e, 0, 128, me);
      EpiF32 ek; ek.C = out + O_PMK; ek.ldc = DM; run_gemm(lds, (const bf16_t*)(ws + W_MN), (const bf16_t*)(ws + W_K), 4096, DM, DM, ek, 32, 128, me);
      EpiF32 ev; ev.C = out + O_PMV; ev.ldc = DM; run_gemm(lds, (const bf16_t*)(ws + W_MN), (const bf16_t*)(ws + W_V), 4096, DM, DM, ev, 96, 128, me); }
    tree_barrier(ctl2, ++k2, me, 4);
    phase_conv(P, lds, NP, NS, (unsigned)(me * 512 + (int)threadIdx.x), 128u * 512u);
    tree_barrier(ctl2, ++k2, me, 4);
}
DI void sample_chain(const Params& P, LAS unsigned char* lds, unsigned* ctl2, unsigned& k2) {
    const int me = blockIdx.x - 128; unsigned char* ws = P.ws; float* Xs = P.out + (size_t)NP * DM;
    bf16_t* XBS = (bf16_t*)(ws + W_XBS); bf16_t* QS = (bf16_t*)(ws + W_QS); bf16_t* HS = (bf16_t*)(ws + W_HS); const bf16_t* HCs = (const bf16_t*)(ws + W_HCAT) + (size_t)NP * DM;
    float* sq1 = (float*)(ws + W_SQ1) + NP; float* sq2 = (float*)(ws + W_SQ2) + NP;
    tree_barrier(ctl2, ++k2, me, 4);
    { EpiResB<true> e; e.resF = P.x_sample; e.resB = nullptr; e.XB = XBS; e.sq = sq1; run_gemm(lds, HCs, (const bf16_t*)(ws + W_OUT), NS, DM, DM, e, 0, 128, me); }
    tree_barrier(ctl2, ++k2, me, 4);
    { EpiBf16<0, true> e; e.O = QS; e.ldc = DM; e.rstd = sq1; run_gemm(lds, XBS, (const bf16_t*)(ws + W_Q), NS, DM, DM, e, 0, 128, me); }
    tree_barrier(ctl2, ++k2, me, 4);
    phase_attn(P, lds, 2048, 2048 + 128, me, 128);
    tree_barrier(ctl2, ++k2, me, 4);
    { EpiResB<false> e; e.resF = nullptr; e.resB = XBS; e.XB = XBS; e.sq = sq2; run_gemm(lds, HCs, (const bf16_t*)(ws + W_O), NS, DM, DM, e, 0, 128, me); }
    tree_barrier(ctl2, ++k2, me, 4);
    { EpiBf16<1, true> e; e.O = HS; e.ldc = DFF; e.rstd = sq2; run_gemm(lds, XBS, (const bf16_t*)(ws + W_1), NS, DFF, DM, e, 0, 128, me); }
    tree_barrier(ctl2, ++k2, me, 4);
    { EpiResB<false> e; e.resF = nullptr; e.resB = XBS; e.XB = XBS; e.sq = nullptr; run_gemm(lds, HS, (const bf16_t*)(ws + W_2), NS, DM, DFF, e, 0, 128, me); }
    tree_barrier(ctl2, ++k2, me, 4);
    phase_final(P, XBS, Xs, NS, me * 8 + (int)(threadIdx.x >> 6), 1024);
}

__global__ __launch_bounds__(512, 2) void mega_fwd(Params P) {
    extern __shared__ __attribute__((aligned(16))) unsigned char shm[];
    LAS unsigned char* lds = (LAS unsigned char*)shm;
    cg::grid_group grid = cg::this_grid();
    unsigned char* ws = P.ws; float* out = P.out; unsigned* ctl = (unsigned*)(ws + W_CTL); unsigned bk = 0;
    phase0(P, lds);
#ifdef PROBE_P0X2
    grid.sync();
    phase0(P, lds);
#endif
    if (blockIdx.x == 0 && threadIdx.x == 0) { Params* t = (Params*)(ws + W_TAB); t->x_prompt = P.x_prompt; t->x_sample = P.x_sample; t->st_C = P.st_C; t->st_n = P.st_n; t->st_m = P.st_m; t->st_S = P.st_S; t->st_conv = P.st_conv; t->cache_k = P.cache_k; t->cache_v = P.cache_v; t->mem_prompt = P.mem_prompt; t->norm_mix_w = P.norm_mix_w; t->w_in = P.w_in; t->ig_b = P.ig_b; t->fg_b = P.fg_b; t->mlstm_norm_w = P.mlstm_norm_w; t->conv_w = P.conv_w; t->A_log = P.A_log; t->dt_bias = P.dt_bias; t->gdn_norm_w = P.gdn_norm_w; t->w_out = P.w_out; t->norm_x_w = P.norm_x_w; t->norm_mem_w = P.norm_mem_w; t->wq = P.wq; t->wk = P.wk; t->wv = P.wv; t->wo = P.wo; t->norm_ffn_w = P.norm_ffn_w; t->w1 = P.w1; t->w2 = P.w2; t->norm_final_w = P.norm_final_w; t->out = P.out; t->ws = P.ws; }
    if (blockIdx.x == 0) for (int i = threadIdx.x; i < 2048; i += 512) ctl[i] = 0u;
    grid.sync();
    const Params& T = *(const Params*)(ws + W_TAB);
    { EpiBf16<0, false> e; e.O = (bf16_t*)(ws + W_PROJ); e.ldc = NMAIN; e.rstd = nullptr;
      run_gemm(lds, (const bf16_t*)(ws + W_XN), (const bf16_t*)(ws + W_IN), NP, NMAIN, DM, e, 0); }
    tree_barrier(ctl, ++bk);
    phase_conv(T, lds, 0, NP, blockIdx.x * 512u + threadIdx.x, gridDim.x * 512u);
#ifdef PROBE_CONVX2
    tree_barrier(ctl, ++bk);
    phase_conv(T, lds);
#endif
    tree_barrier(ctl, ++bk);
    unsigned k2 = 0;
    if (blockIdx.x >= 128) sample_pre(T, lds, ctl + 1024, k2);
    phase2(T, lds, -1);
    if (blockIdx.x >= 128) sample_chain(T, lds, ctl + 1024, k2);
    tree_barrier(ctl, ++bk);
    { EpiResB<true> e; e.resF = T.x_prompt; e.resB = nullptr; e.XB = (bf16_t*)(ws + W_XN); e.sq = (float*)(ws + W_SQ1); run_gemm(lds, (const bf16_t*)(ws + W_HCAT), (const bf16_t*)(ws + W_OUT), NP, DM, DM, e, 0); }
    tree_barrier(ctl, ++bk);
    { EpiBf16<0, true> e; e.O = (bf16_t*)(ws + W_PROJ); e.ldc = DM; e.rstd = (const float*)(ws + W_SQ1); run_gemm(lds, (const bf16_t*)(ws + W_XN), (const bf16_t*)(ws + W_Q), NP, DM, DM, e, 0); }
    tree_barrier(ctl, ++bk);
    phase_attn(T, lds, 0, 2048, (int)blockIdx.x, (int)gridDim.x);
    tree_barrier(ctl, ++bk);
    { EpiResB<false> e; e.resF = nullptr; e.resB = (const bf16_t*)(ws + W_XN); e.XB = (bf16_t*)(ws + W_XN); e.sq = (float*)(ws + W_SQ2); run_gemm(lds, (const bf16_t*)(ws + W_HCAT), (const bf16_t*)(ws + W_O), NP, DM, DM, e, 0); }
    tree_barrier(ctl, ++bk);
    { EpiBf16<1, true> e; e.O = (bf16_t*)(ws + W_PROJ); e.ldc = DFF; e.rstd = (const float*)(ws + W_SQ2); run_gemm(lds, (const bf16_t*)(ws + W_XN), (const bf16_t*)(ws + W_1), NP, DFF, DM, e, 0); }
    tree_barrier(ctl, ++bk);
    { EpiResB<false> e; e.resF = nullptr; e.resB = (const bf16_t*)(ws + W_XN); e.XB = (bf16_t*)(ws + W_XN); e.sq = nullptr; run_gemm(lds, (const bf16_t*)(ws + W_PROJ), (const bf16_t*)(ws + W_2), NP, DM, DFF, e, 0); }
    tree_barrier(ctl, ++bk);
    phase_final(T, (const bf16_t*)(ws + W_XN), out, NP, (int)(blockIdx.x * 8 + (threadIdx.x >> 6)), (int)gridDim.x * 8);
#ifdef PROBE_SYNCX
    for (int i = 0; i < PROBE_SYNCX; ++i) tree_barrier(ctl, ++bk);
#endif
}

extern "C" void kernel_launch(void* const* d_in, const int* in_sizes, int n_in, void* d_out, int out_size, void* d_ws, size_t ws_size, hipStream_t stream) {
    static int grid_blocks = 0;
    if (grid_blocks == 0) {
        if (n_in != 30 || (size_t)out_size != O_END || ws_size < W_END) { fprintf(stderr, "kernel_launch: unexpected shapes: n_in %d out %d ws %zu (need %zu)\n", n_in, out_size, ws_size, (size_t)W_END); grid_blocks = -1; return; }
        int dev = 0, cus = 0, per_cu = 0;
        hipGetDevice(&dev);
        hipDeviceGetAttribute(&cus, hipDeviceAttributeMultiprocessorCount, dev);
        if (hipFuncSetAttribute((const void*)mega_fwd, hipFuncAttributeMaxDynamicSharedMemorySize, LDS_BYTES) != hipSuccess) { fprintf(stderr, "kernel_launch: hipFuncSetAttribute failed\n"); grid_blocks = -1; return; }
        if (hipOccupancyMaxActiveBlocksPerMultiprocessor(&per_cu, (const void*)mega_fwd, 512, LDS_BYTES) != hipSuccess || per_cu < 1) { fprintf(stderr, "kernel_launch: occupancy query gave %d\n", per_cu); (void)hipGetLastError(); grid_blocks = -1; return; }
        grid_blocks = cus * per_cu;
        if (grid_blocks != 256) { fprintf(stderr, "kernel_launch: expected 256 resident workgroups, got %d\n", grid_blocks); grid_blocks = -1; return; }
    }
    if (grid_blocks < 0) return;
    Params p{};
    const float* const* in = (const float* const*)d_in;
    p.x_prompt = in[0]; p.x_sample = in[1]; p.st_C = in[2]; p.st_n = in[3]; p.st_m = in[4]; p.st_S = in[5]; p.st_conv = in[6]; p.cache_k = in[7]; p.cache_v = in[8]; p.mem_prompt = in[9];
    p.norm_mix_w = in[10]; p.w_in = in[11]; p.ig_b = in[12]; p.fg_b = in[13]; p.mlstm_norm_w = in[14]; p.conv_w = in[15]; p.A_log = in[16]; p.dt_bias = in[17]; p.gdn_norm_w = in[18]; p.w_out = in[19];
    p.norm_x_w = in[20]; p.norm_mem_w = in[21]; p.wq = in[22]; p.wk = in[23]; p.wv = in[24]; p.wo = in[25]; p.norm_ffn_w = in[26]; p.w1 = in[27]; p.w2 = in[28]; p.norm_final_w = in[29];
    p.out = (float*)d_out; p.ws = (unsigned char*)d_ws;
    void* args[] = {&p};
    hipError_t e = hipLaunchCooperativeKernel((const void*)mega_fwd, dim3(grid_blocks), dim3(512), args, LDS_BYTES, stream);
    if (e != hipSuccess) fprintf(stderr, "cooperative launch failed: %s (grid %d)\n", hipGetErrorString(e), grid_blocks);
}
```

```cpp
#include <hip/hip_cooperative_groups.h>
#include <cstdio>
#include <cstdint>
#include <hip/hip_runtime.h>
namespace pg8 {
#define PG8_LAS __attribute__((address_space(3)))
typedef unsigned short bf16_t;
typedef short bf16x8 __attribute__((ext_vector_type(8)));
typedef float f32x4 __attribute__((ext_vector_type(4)));
typedef unsigned u32x4 __attribute__((ext_vector_type(4)));
constexpr int BM = 256, BK = 64, HALF = 128, HTB = HALF * BK * 2  , STAGE_BYTES = 8 * HTB, NXCD = 8, WGM = 8;

__host__ __device__ __forceinline__ int lds_byte(int r, int c) { const int st = (r >> 4) * 2 + (c >> 5), rr = r & 15, cc = c & 31, ob = rr * 64 + cc * 2; return st * 1024 + (ob ^ (((ob >> 9) & 1) << 5)); }
__host__ __device__ __forceinline__ void stage_rc(int b, int& R, int& C) { const int st = b / 1024, sb = b % 1024, swz = sb ^ (((sb >> 9) & 1) << 5); R = (st >> 1) * 16 + swz / 64; C = (st & 1) * 32 + (swz % 64) / 2; }
__host__ __device__ __forceinline__ int perm32(int rho) { const int n = rho >> 4, i = rho & 15; return 8 * (i >> 2) + 4 * n + (i & 3); }

struct Unit { int pm, pn; };
struct Gemm { const bf16_t* A; const bf16_t* Bt; int M, N, K; };

struct StaticOrder {
    int nM, nN, nwg, G, c;
    __host__ __device__ void init(int M, int N, int G_, int c_) { nM = M / BM; nN = N / BM; nwg = nM * nN; G = G_; c = c_; }
    __host__ __device__ bool next(int i, Unit& u) const {
        const long L = (long)i * G + c; if (L >= nwg) return false;
        int wgid = (int)L; { const int q = nwg / NXCD, r = nwg % NXCD, xcd = wgid % NXCD, off = wgid / NXCD; wgid = (xcd < r ? xcd * (q + 1) : r * (q + 1) + (xcd - r) * q) + off; }
        const int nig = WGM * nN, gid = wgid / nig, fm = gid * WGM, gsz = (nM - fm) < WGM ? (nM - fm) : WGM;
        u.pm = fm + ((wgid % nig) % gsz); u.pn = (wgid % nig) / gsz; return true;
    }
    __device__ __forceinline__ void a_ready(const Unit&) const {}
    __device__ __forceinline__ void done(const Unit&) const {}
};
__device__ __forceinline__ unsigned cvt_pk_bf16(float lo, float hi) { unsigned r; asm volatile("v_cvt_pk_bf16_f32 %0, %1, %2" : "=v"(r) : "v"(lo), "v"(hi)); return r; }

template <class Epi, class Sched, bool STAMP = false>
__device__ __forceinline__ void gemm_phase(PG8_LAS unsigned char* lds, const Gemm g, const Sched& S, const Epi& E, unsigned long long* stamps) {
    int tid_ = threadIdx.x; asm volatile("" : "+v"(tid_)); const int tid = tid_, wid = __builtin_amdgcn_readfirstlane(tid >> 6), lane = tid & 63, wr = wid >> 2, wc = wid & 3, fr = lane & 15, fq = lane >> 4;
    const int K = g.K, nt = K / BK;
    int ts_lo = 0, ts_hi = 0, nts = 0; const unsigned long long rt_entry = STAMP ? (unsigned long long)wall_clock64() : 0ull;
#define PG8_STAMP() do { if (STAMP && wid == 0 && nts < 64) { const unsigned long long _c = (unsigned long long)clock64(); \
        ts_lo = (lane == nts) ? (int)(unsigned)_c : ts_lo; ts_hi = (lane == nts) ? (int)(unsigned)(_c >> 32) : ts_hi; ++nts; } } while (0)
    PG8_STAMP();
    unsigned voffA[2], voffB[2];
#pragma unroll
    for (int i = 0; i < 2; ++i) { int R, C; stage_rc(tid * 16 + i * 8192, R, C); const int Rb = Epi::PERM ? ((R & ~31) + perm32(R & 31)) : R;
        voffA[i] = (unsigned)(R * K + C) * 2u; voffB[i] = (unsigned)(Rb * K + C) * 2u; }
    const size_t kstep = (size_t)(BK * 2);
    const size_t hstep = (size_t)HALF * K * 2;
    const size_t tstep = 2 * hstep;
    const unsigned ldsw = (unsigned)wid * 1024u;
    const int aoff = lds_byte(wr * 64 + fr, fq * 8), boff = lds_byte(wc * 32 + fr, fq * 8);
#define PG8_SA(b, h) (((b) * 2 + (h)) * HTB)
#define PG8_SB(b, h) ((4 + (b) * 2 + (h)) * HTB)
#define PG8_STAGE(bufoff, gbase, voff) do { _Pragma("unroll") for (int _i = 0; _i < 2; ++_i) \
        __builtin_amdgcn_global_load_lds((const unsigned*)((const char*)(gbase) + (voff)[_i]), (PG8_LAS unsigned*)(lds + (bufoff) + ldsw + _i * 8192), 16, 0, 0); } while (0)
#define PG8_LDA(dst, b, h) do { _Pragma("unroll") for (int m = 0; m < 4; ++m) _Pragma("unroll") for (int k = 0; k < 2; ++k) dst[m][k] = *(const PG8_LAS bf16x8*)(lds + PG8_SA(b, h) + aoff + m * 2048 + k * 1024); } while (0)
#define PG8_LDB(dst, b, h) do { _Pragma("unroll") for (int n = 0; n < 2; ++n) _Pragma("unroll") for (int k = 0; k < 2; ++k) dst[n][k] = *(const PG8_LAS bf16x8*)(lds + PG8_SB(b, h) + boff + n * 2048 + k * 1024); } while (0)
#define PG8_MMA(ai, bj, At, Bt) do { __builtin_amdgcn_s_setprio(1); _Pragma("unroll") for (int m = 0; m < 4; ++m) _Pragma("unroll") for (int n = 0; n < 2; ++n) _Pragma("unroll") for (int k = 0; k < 2; ++k) \
        acc[ai][bj][m][n] = __builtin_amdgcn_mfma_f32_16x16x32_bf16(Bt[n][k], At[m][k], acc[ai][bj][m][n], 0, 0, 0); __builtin_amdgcn_s_setprio(0); } while (0)
#define PG8_WAIT_V(n) asm volatile("s_waitcnt vmcnt(" #n ")" ::: "memory")
#define PG8_WAIT_L(n) asm volatile("s_waitcnt lgkmcnt(" #n ")" ::: "memory")
#define PG8_BAR __builtin_amdgcn_s_barrier()
#define PG8_SCHED __builtin_amdgcn_sched_barrier(0)
    Unit cur, nxt; int ui = 0;
    if (!S.next(0, cur)) return;
    f32x4 acc[2][2][4][2];
#pragma unroll
    for (int a = 0; a < 2; ++a)
#pragma unroll
        for (int b = 0; b < 2; ++b)
#pragma unroll
            for (int m = 0; m < 4; ++m)
#pragma unroll
                for (int n = 0; n < 2; ++n) acc[a][b][m][n] = (f32x4){0.f, 0.f, 0.f, 0.f};
    bf16x8 At[4][2], B0[2][2], B1[2][2];
    const char* cA = (const char*)g.A + (size_t)cur.pm * tstep; const char* cB = (const char*)g.Bt + (size_t)cur.pn * tstep;
    S.a_ready(cur);
    PG8_STAGE(PG8_SB(0, 0), cB, voffB); PG8_STAGE(PG8_SA(0, 0), cA, voffA); PG8_STAGE(PG8_SB(0, 1), cB + hstep, voffB); PG8_STAGE(PG8_SA(0, 1), cA + hstep, voffA);
    if (wr == 1) PG8_BAR;
    PG8_WAIT_V(4); PG8_BAR;
    PG8_STAGE(PG8_SB(1, 0), cB + kstep, voffB); PG8_STAGE(PG8_SA(1, 0), cA + kstep, voffA); PG8_STAGE(PG8_SB(1, 1), cB + hstep + kstep, voffB);
    PG8_WAIT_V(6); PG8_BAR;
    PG8_STAMP();
    for (;;) {
        const bool has_next = S.next(ui + 1, nxt);
        const char* nA = has_next ? (const char*)g.A + (size_t)nxt.pm * tstep : cA; const char* nB = has_next ? (const char*)g.Bt + (size_t)nxt.pn * tstep : cB;
        for (int t = 0; t < nt; t += 2) {
            const bool last = (t == nt - 2);
            const char* a1 = cA + (size_t)(t + 1) * kstep;
            const char* a2 = last ? nA : cA + (size_t)(t + 2) * kstep; const char* b2 = last ? nB : cB + (size_t)(t + 2) * kstep;
            const char* a3 = a2 + kstep; const char* b3 = b2 + kstep;
            if (last && has_next) S.a_ready(nxt);
            PG8_LDB(B0, 0, 0); PG8_SCHED; PG8_LDA(At, 0, 0); PG8_STAGE(PG8_SA(1, 1), a1 + hstep, voffA);
            PG8_WAIT_L(8); PG8_BAR; PG8_WAIT_L(0); PG8_MMA(0, 0, At, B0); PG8_BAR; PG8_SCHED;
            PG8_LDB(B1, 0, 1); PG8_STAGE(PG8_SB(0, 0), b2, voffB);
            PG8_BAR; PG8_WAIT_L(0); PG8_MMA(0, 1, At, B1); PG8_BAR;
            PG8_LDA(At, 0, 1); PG8_STAGE(PG8_SA(0, 0), a2, voffA);
            PG8_BAR; PG8_WAIT_L(0); PG8_MMA(1, 0, At, B0); PG8_BAR; PG8_SCHED;
            PG8_STAGE(PG8_SB(0, 1), b2 + hstep, voffB);
            PG8_WAIT_V(6); PG8_BAR; PG8_MMA(1, 1, At, B1); PG8_BAR;
            PG8_LDB(B0, 1, 0); PG8_SCHED; PG8_LDA(At, 1, 0); PG8_STAGE(PG8_SA(0, 1), a2 + hstep, voffA);
            PG8_WAIT_L(8); PG8_BAR; PG8_WAIT_L(0); PG8_MMA(0, 0, At, B0); PG8_BAR; PG8_SCHED;
            PG8_LDB(B1, 1, 1); PG8_STAGE(PG8_SB(1, 0), b3, voffB);
            PG8_BAR; PG8_WAIT_L(0); PG8_MMA(0, 1, At, B1); PG8_BAR;
            PG8_LDA(At, 1, 1); PG8_STAGE(PG8_SA(1, 0), a3, voffA);
            PG8_BAR; PG8_WAIT_L(0); PG8_MMA(1, 0, At, B0); PG8_BAR; PG8_SCHED;
            PG8_STAGE(PG8_SB(1, 1), b3 + hstep, voffB);
            PG8_WAIT_V(6); PG8_BAR; PG8_MMA(1, 1, At, B1); PG8_BAR;
        }
        PG8_STAMP();
        if constexpr (!Epi::AFTER_DRAIN) { E(acc, cur, wr, wc, fr, fq); S.done(cur); }
        PG8_STAMP();
        if (!has_next) break;
#pragma unroll
        for (int a = 0; a < 2; ++a)
#pragma unroll
            for (int b = 0; b < 2; ++b)
#pragma unroll
                for (int m = 0; m < 4; ++m)
#pragma unroll
                    for (int n = 0; n < 2; ++n) acc[a][b][m][n] = (f32x4){0.f, 0.f, 0.f, 0.f};
        cur = nxt; cA = nA; cB = nB; ++ui;
    }
    PG8_WAIT_V(0);
    if (wr == 0) PG8_BAR;
    PG8_BAR;
    if constexpr (Epi::AFTER_DRAIN) { E.fused(acc, cur, wr, wc, fr, fq, lds, wid, lane); S.done(cur); }
    PG8_STAMP();
    if (STAMP && wid == 0) { stamps[lane] = lane < nts ? (((unsigned long long)(unsigned)ts_hi << 32) | (unsigned)ts_lo) : 0ull;
        if (lane == 62) stamps[62] = rt_entry; if (lane == 63) stamps[63] = (unsigned long long)wall_clock64(); }
#undef PG8_STAMP
#undef PG8_SA
#undef PG8_SB
#undef PG8_STAGE
#undef PG8_LDA
#undef PG8_LDB
#undef PG8_MMA
#undef PG8_WAIT_V
#undef PG8_WAIT_L
#undef PG8_BAR
#undef PG8_SCHED
}
}

#ifndef STOP_AFTER
#define STOP_AFTER 99
#endif
namespace cg = cooperative_groups;
using pg8::bf16_t; using pg8::bf16x8; using pg8::f32x4; using pg8::u32x4; using pg8::Unit;
#define LAS __attribute__((address_space(3)))
#define DI __device__ __forceinline__
typedef unsigned u32x2 __attribute__((ext_vector_type(2)));

constexpr int DM = 1024, NP = 65536, NS = 512, NTOK = NP + NS, SEQ = 4096, NB_P = 16, NB_S = 32, TS = 16;
constexpr int INC = 4112, NMAIN = 4096, DFF = 4096, NMEM = 256;
constexpr float EPS = 1e-6f;
constexpr float SCALE_H = 0.08838834764831845f;
constexpr size_t O_Y = 0, O_PC = (size_t)NTOK * DM, O_PN = O_PC + 16 * 4 * 128 * 128, O_PM = O_PN + 16 * 4 * 128, O_PS = O_PM + 64,
                 O_PCONV = O_PS + 16 * 4 * 128 * 128, O_PMK = O_PCONV + 16 * 3 * 1536, O_PMV = O_PMK + (size_t)16 * 256 * 1024,
                 O_SC = O_PMV + (size_t)16 * 256 * 1024, O_SN = O_SC + 32 * 4 * 128 * 128, O_SM = O_SN + 32 * 4 * 128, O_SS = O_SM + 128,
                 O_SCONV = O_SS + 32 * 4 * 128 * 128, O_END = O_SCONV + 32 * 3 * 1536;
constexpr size_t W_IN = 0, W_OUT = W_IN + (size_t)NMAIN * DM * 2, W_Q = W_OUT + (size_t)DM * DM * 2, W_K = W_Q + (size_t)DM * DM * 2, W_V = W_K + (size_t)DM * DM * 2,
                 W_O = W_V + (size_t)DM * DM * 2, W_1 = W_O + (size_t)DM * DM * 2, W_2 = W_1 + (size_t)DFF * DM * 2,
                 W_PROJ = W_2 + (size_t)DFF * DM * 2, W_HCAT = W_PROJ + (size_t)NTOK * NMAIN * 2, W_GATES = W_HCAT + (size_t)NTOK * DM * 2,
                 W_MN = W_GATES + (size_t)NTOK * 16 * 4, W_KBP = W_MN + (size_t)4096 * DM * 2, W_VTP = W_KBP + (size_t)4096 * DM * 2,
                 W_KBS = W_VTP + (size_t)4096 * DM * 2, W_VTS = W_KBS + (size_t)8192 * DM * 2, W_TAB = W_VTS + (size_t)8192 * DM * 2,
                 W_XBS = W_TAB + 4096  , W_QS = W_XBS + (size_t)NS * DM * 2  , W_HS = W_QS + (size_t)NS * DM * 2  , W_CTL = W_HS + (size_t)NS * DFF * 2  , W_SQ1 = W_CTL + 8192, W_SQ2 = W_SQ1 + (size_t)NTOK * 64, W_RS1 = W_SQ2 + (size_t)NTOK * 64, W_RS2 = W_RS1 + (size_t)NTOK * 4, W_XN = W_RS2 + (size_t)NTOK * 4, W_QKVC = W_XN  , W_END = W_XN + (size_t)NTOK * 1536 * 2;
constexpr int LDS_BYTES = 156 * 1024;

struct Params {
    const float *x_prompt, *x_sample, *st_C, *st_n, *st_m, *st_S, *st_conv, *cache_k, *cache_v, *mem_prompt;
    const float *norm_mix_w, *w_in, *ig_b, *fg_b, *mlstm_norm_w, *conv_w, *A_log, *dt_bias, *gdn_norm_w, *w_out;
    const float *norm_x_w, *norm_mem_w, *wq, *wk, *wv, *wo, *norm_ffn_w, *w1, *w2, *norm_final_w;
    float* out; unsigned char* ws;
};

DI unsigned pk2(float lo, float hi) { unsigned r; asm("v_cvt_pk_bf16_f32 %0, %1, %2" : "=v"(r) : "v"(lo), "v"(hi)); return r; }
DI unsigned pk2a(float lo, float hi) { unsigned r; asm volatile("v_cvt_pk_bf16_f32 %0, %1, %2" : "=v"(r) : "v"(lo), "v"(hi)); return r; }
typedef short s16x4 __attribute__((ext_vector_type(4)));
typedef float f32x2_ __attribute__((ext_vector_type(2)));
typedef __bf16 bf16x2_ __attribute__((ext_vector_type(2)));
DI s16x4 pack4(f32x4 v) { const f32x2_ a = {v.x, v.y}, b = {v.z, v.w}; u32x2 u; u.x = __builtin_bit_cast(unsigned, __builtin_convertvector(a, bf16x2_)); u.y = __builtin_bit_cast(unsigned, __builtin_convertvector(b, bf16x2_)); return __builtin_bit_cast(s16x4, u); }
DI bf16_t f2bf(float f) { return __builtin_bit_cast(unsigned short, (__bf16)f); }
DI float bf2f(bf16_t b) { return __uint_as_float(((unsigned)b) << 16); }
DI float bflo(unsigned u) { return __uint_as_float(u << 16); }
DI float bfhi(unsigned u) { return __uint_as_float(u & 0xffff0000u); }
DI int get_tid() { int t = threadIdx.x; asm volatile("" : "+v"(t)); return t; }
DI float wave_sum(float v) {
#pragma unroll
    for (int o = 1; o < 64; o <<= 1) v += __shfl_xor(v, o);
    return v;
}
DI float sigmoidf_(float x) { return 1.f / (1.f + __expf(-x)); }
#define LDS_WAIT() asm volatile("s_waitcnt lgkmcnt(0)" ::: "memory")
DI void lds_barrier() { asm volatile("s_waitcnt lgkmcnt(0)" ::: "memory"); __builtin_amdgcn_s_barrier(); asm volatile("" ::: "memory"); }

template <int K> DI f32x4 mm16(const LAS bf16_t* A, int lda, const LAS bf16_t* B, int ldb, f32x4 acc, int lane) {
    const LAS bf16_t* pa = A + (lane & 15) * lda + (lane >> 4) * 8;
    const LAS bf16_t* pb = B + (lane & 15) * ldb + (lane >> 4) * 8;
#pragma unroll
    for (int k = 0; k < K; k += 32) {
        const bf16x8 a = *(const LAS bf16x8*)(pa + k), b = *(const LAS bf16x8*)(pb + k);
        acc = __builtin_amdgcn_mfma_f32_16x16x32_bf16(a, b, acc, 0, 0, 0);
    }
    return acc;
}

template <int ACT, bool ROWSCALE> struct EpiBf16 {
    static constexpr bool PERM = true, AFTER_DRAIN = false;
    bf16_t* O; int ldc; const float* rstd;
    DI void operator()(const f32x4 (&acc)[2][2][4][2], const Unit& u, int wr, int wc, int fr, int fq) const {
        const int row0 = u.pm * 256 + wr * 64 + fr, col0 = u.pn * 256 + wc * 32 + 8 * fq;
        float rsv[2][4];
        if (ROWSCALE) {
#pragma unroll
            for (int ai = 0; ai < 2; ++ai)
#pragma unroll
                for (int m = 0; m < 4; ++m) rsv[ai][m] = rsqrtf(rstd[row0 + ai * 128 + m * 16] * (1.f / DM) + EPS); }
#pragma unroll
        for (int ai = 0; ai < 2; ++ai)
#pragma unroll
            for (int m = 0; m < 4; ++m) { const int row = row0 + ai * 128 + m * 16; bf16_t* rowp = O + (size_t)row * ldc + col0; const float rs = ROWSCALE ? rsv[ai][m] : 1.f;
#pragma unroll
                for (int bj = 0; bj < 2; ++bj) { f32x4 v0 = acc[ai][bj][m][0], v1 = acc[ai][bj][m][1];
                    if (ROWSCALE) { v0 = v0 * rs; v1 = v1 * rs; }
                    if (ACT == 1) {
#pragma unroll
                        for (int e = 0; e < 4; ++e) { float a = fmaxf(v0[e], 0.f), b = fmaxf(v1[e], 0.f); v0[e] = a * a; v1[e] = b * b; } }
                    u32x4 o; o.x = pk2a(v0[0], v0[1]); o.y = pk2a(v0[2], v0[3]); o.z = pk2a(v1[0], v1[1]); o.w = pk2a(v1[2], v1[3]);
                    *(u32x4*)(rowp + bj * 128) = o; } }
    }
};
struct EpiF32 {
    static constexpr bool PERM = false, AFTER_DRAIN = false;
    float* C; int ldc;
    DI void operator()(const f32x4 (&acc)[2][2][4][2], const Unit& u, int wr, int wc, int fr, int fq) const {
        const int row0 = u.pm * 256 + wr * 64 + fr, col0 = u.pn * 256 + wc * 32 + 4 * fq;
#pragma unroll
        for (int ai = 0; ai < 2; ++ai)
#pragma unroll
            for (int m = 0; m < 4; ++m) { float* rowp = C + (size_t)(row0 + ai * 128 + m * 16) * ldc + col0;
#pragma unroll
                for (int bj = 0; bj < 2; ++bj)
#pragma unroll
                    for (int n = 0; n < 2; ++n) *(f32x4*)(rowp + bj * 128 + n * 16) = acc[ai][bj][m][n]; }
    }
};
struct EpiRes {
    static constexpr bool PERM = false, AFTER_DRAIN = false;
    float* out; const float* resP; const float* resS;
    DI void operator()(const f32x4 (&acc)[2][2][4][2], const Unit& u, int wr, int wc, int fr, int fq) const {
        const int row0 = u.pm * 256 + wr * 64 + fr, col0 = u.pn * 256 + wc * 32 + 4 * fq;
        const float* rbase = (u.pm < NP / 256) ? resP + (size_t)row0 * DM : resS + (size_t)(row0 - NP) * DM;
#pragma unroll
        for (int ai = 0; ai < 2; ++ai)
#pragma unroll
            for (int m = 0; m < 4; ++m) { const size_t ro = (size_t)(ai * 128 + m * 16) * DM + col0; const float* rp = rbase + ro; float* op = out + (size_t)row0 * DM + ro;
#pragma unroll
                for (int bj = 0; bj < 2; ++bj)
#pragma unroll
                    for (int n = 0; n < 2; ++n) *(f32x4*)(op + bj * 128 + n * 16) = *(const f32x4*)(rp + bj * 128 + n * 16) + acc[ai][bj][m][n]; }
    }
};
struct EpiResSq {
    static constexpr bool PERM = false, AFTER_DRAIN = false;
    float* out; const float* resP; const float* resS; bf16_t* XB; float* sq;
    DI void operator()(const f32x4 (&acc)[2][2][4][2], const Unit& u, int wr, int wc, int fr, int fq) const {
        const int row0 = u.pm * 256 + wr * 64 + fr, col0 = u.pn * 256 + wc * 32 + 4 * fq;
        const float* rbase = (u.pm < NP / 256) ? resP + (size_t)row0 * DM : resS + (size_t)(row0 - NP) * DM;
#pragma unroll
        for (int ai = 0; ai < 2; ++ai)
#pragma unroll
            for (int m = 0; m < 4; ++m) { const size_t ro = (size_t)(ai * 128 + m * 16) * DM + col0; const float* rp = rbase + ro; float* op = out + (size_t)row0 * DM + ro; bf16_t* xp = XB + (size_t)row0 * DM + ro;
                float ss = 0.f;
#pragma unroll
                for (int bj = 0; bj < 2; ++bj)
#pragma unroll
                    for (int n = 0; n < 2; ++n) { const f32x4 v = *(const f32x4*)(rp + bj * 128 + n * 16) + acc[ai][bj][m][n]; *(f32x4*)(op + bj * 128 + n * 16) = v;
                        ss += (v.x * v.x + v.y * v.y) + (v.z * v.z + v.w * v.w);
                        u32x2 o; o.x = pk2(v.x, v.y); o.y = pk2(v.z, v.w); *(u32x2*)(xp + bj * 128 + n * 16) = o; }
                ss += __shfl_xor(ss, 16); ss += __shfl_xor(ss, 32);
                if (fq == 0) sq[(size_t)(row0 + ai * 128 + m * 16) * 16 + u.pn * 4 + wc] = ss; }
    }
};
template <bool RESF32> struct EpiResB {
    static constexpr bool PERM = true, AFTER_DRAIN = false;
    const float* resF; const bf16_t* resB; bf16_t* XB; float* sq;
    DI void finish(f32x4 v0, f32x4 v1, float& ss, bf16_t* dst) const {
        ss += ((v0.x * v0.x + v0.y * v0.y) + (v0.z * v0.z + v0.w * v0.w)) + ((v1.x * v1.x + v1.y * v1.y) + (v1.z * v1.z + v1.w * v1.w));
        u32x4 o; o.x = pk2(v0.x, v0.y); o.y = pk2(v0.z, v0.w); o.z = pk2(v1.x, v1.y); o.w = pk2(v1.z, v1.w);
        *(u32x4*)dst = o; }
    DI void rowsum(float ss, int row, int fq) const {
        ss += __shfl_xor(ss, 16); ss += __shfl_xor(ss, 32);
        if (fq == 0 && sq) __hip_atomic_fetch_add(sq + row, ss, __ATOMIC_RELAXED, __HIP_MEMORY_SCOPE_AGENT); }
    DI void operator()(const f32x4 (&acc)[2][2][4][2], const Unit& u, int wr, int wc, int fr, int fq) const {
        const int row0 = u.pm * 256 + wr * 64 + fr, col0 = u.pn * 256 + wc * 32 + 8 * fq;
        if (!RESF32) {
#pragma unroll
            for (int ai = 0; ai < 2; ++ai) { u32x4 rr[4][2];
#pragma unroll
                for (int m = 0; m < 4; ++m)
#pragma unroll
                    for (int bj = 0; bj < 2; ++bj) rr[m][bj] = *(const u32x4*)(resB + (size_t)(row0 + ai * 128 + m * 16) * DM + col0 + bj * 128);
#pragma unroll
                for (int m = 0; m < 4; ++m) { const size_t ro = (size_t)(row0 + ai * 128 + m * 16) * DM + col0; float ss = 0.f;
#pragma unroll
                    for (int bj = 0; bj < 2; ++bj) { f32x4 v0 = acc[ai][bj][m][0], v1 = acc[ai][bj][m][1]; const u32x4 r = rr[m][bj];
                        v0.x += bflo(r.x); v0.y += bfhi(r.x); v0.z += bflo(r.y); v0.w += bfhi(r.y); v1.x += bflo(r.z); v1.y += bfhi(r.z); v1.z += bflo(r.w); v1.w += bfhi(r.w);
                        finish(v0, v1, ss, XB + ro + bj * 128); }
                    rowsum(ss, row0 + ai * 128 + m * 16, fq); } }
        } else {
#pragma unroll
            for (int ai = 0; ai < 2; ++ai) { f32x4 rf[4][2][2];
#pragma unroll
                for (int m = 0; m < 4; ++m)
#pragma unroll
                    for (int bj = 0; bj < 2; ++bj) { const float* rp = resF + (size_t)(row0 + ai * 128 + m * 16) * DM + col0 + bj * 128; rf[m][bj][0] = *(const f32x4*)rp; rf[m][bj][1] = *(const f32x4*)(rp + 4); }
#pragma unroll
                for (int m = 0; m < 4; ++m) { const size_t ro = (size_t)(row0 + ai * 128 + m * 16) * DM + col0; float ss = 0.f;
#pragma unroll
                    for (int bj = 0; bj < 2; ++bj) finish(acc[ai][bj][m][0] + rf[m][bj][0], acc[ai][bj][m][1] + rf[m][bj][1], ss, XB + ro + bj * 128);
                    rowsum(ss, row0 + ai * 128 + m * 16, fq); } }
        }
    }
};
template <class Epi> DI void run_gemm(LAS unsigned char* lds, const bf16_t* A, const bf16_t* Bt, int M, int N, int K, const Epi& E, int cshift, int G = 0, int c0 = 0) {
    pg8::Gemm g; g.A = A; g.Bt = Bt; g.M = M; g.N = N; g.K = K;
    if (G == 0) { G = (int)gridDim.x; c0 = (int)blockIdx.x; }
    pg8::StaticOrder S; S.init(M, N, G, (c0 + G - cshift) % G);
    pg8::gemm_phase<Epi, pg8::StaticOrder, false>(lds, g, S, E, nullptr);
    __syncthreads();
}

DI void transpose_item(const float* src, int ld, bf16_t* dst, int ldd, LAS float* scr, int k0, int n0, int lane, const float* ksc = nullptr) {
#pragma unroll
    for (int i = 0; i < 32; ++i) { const int kk = 2 * i + (lane >> 5); float x = src[(size_t)(k0 + kk) * ld + n0 + (lane & 31)]; if (ksc) x *= ksc[k0 + kk]; scr[kk * 33 + (lane & 31)] = x; }
    LDS_WAIT();
    const int c = lane & 7;
#pragma unroll
    for (int j = 0; j < 4; ++j) { const int n = (lane >> 3) + 8 * j; const LAS float* s = scr + (8 * c) * 33 + n;
        u32x4 o; o.x = pk2(s[0 * 33], s[1 * 33]); o.y = pk2(s[2 * 33], s[3 * 33]); o.z = pk2(s[4 * 33], s[5 * 33]); o.w = pk2(s[6 * 33], s[7 * 33]);
        *(u32x4*)(dst + (size_t)(n0 + n) * ldd + k0 + 8 * c) = o; }
    LDS_WAIT();
}
DI void load_row(f32x4 (&v)[4], const float* xrow, int lane) {
#pragma unroll
    for (int j = 0; j < 4; ++j) v[j] = *(const f32x4*)(xrow + 4 * lane + 256 * j);
}
template <bool GATES> DI void norm_row(f32x4 (&v)[4], const float* w, bf16_t* orow, float* grow, const LAS float* wg, int lane) {
    float s = 0.f;
#pragma unroll
    for (int j = 0; j < 4; ++j) s += (v[j].x * v[j].x + v[j].y * v[j].y) + (v[j].z * v[j].z + v[j].w * v[j].w);
    const float rstd = rsqrtf(wave_sum(s) * (1.f / DM) + EPS);
#pragma unroll
    for (int j = 0; j < 4; ++j) { const f32x4 wv = *(const f32x4*)(w + 4 * lane + 256 * j); v[j] = v[j] * rstd * wv;
        u32x2 o; o.x = pk2(v[j].x, v[j].y); o.y = pk2(v[j].z, v[j].w); *(u32x2*)(orow + 4 * lane + 256 * j) = o; }
    if (GATES) {
        float g[16];
#pragma unroll
        for (int gi = 0; gi < 16; ++gi) { float a = 0.f;
#pragma unroll
            for (int j = 0; j < 4; ++j) { const f32x4 ww = *(const LAS f32x4*)(wg + gi * 1024 + 4 * lane + 256 * j); a += (v[j].x * ww.x + v[j].y * ww.y) + (v[j].z * ww.z + v[j].w * ww.w); }
            g[gi] = a; }
#pragma unroll
        for (int i = 0; i < 8; ++i) { const bool up = lane & 1; const float send = up ? g[i] : g[i + 8], keep = up ? g[i + 8] : g[i]; g[i] = keep + __shfl_xor(send, 1); }
#pragma unroll
        for (int i = 0; i < 4; ++i) { const bool up = lane & 2; const float send = up ? g[i] : g[i + 4], keep = up ? g[i + 4] : g[i]; g[i] = keep + __shfl_xor(send, 2); }
#pragma unroll
        for (int i = 0; i < 2; ++i) { const bool up = lane & 4; const float send = up ? g[i] : g[i + 2], keep = up ? g[i + 2] : g[i]; g[i] = keep + __shfl_xor(send, 4); }
        { const bool up = lane & 8; const float send = up ? g[0] : g[1], keep = up ? g[1] : g[0]; g[0] = keep + __shfl_xor(send, 8); }
        g[0] += __shfl_xor(g[0], 16); g[0] += __shfl_xor(g[0], 32);
        const int idx = ((lane & 1) << 3) | ((lane & 2) << 1) | ((lane & 4) >> 1) | ((lane & 8) >> 3);
        if (lane < 16) grow[idx] = g[0];
    }
}
DI void norm_row2_gates(f32x4 (&v0)[4], f32x4 (&v1)[4], const float* w, bf16_t* orow0, bf16_t* orow1, float* grow0, float* grow1, const LAS float* wg, int lane) {
    float s0 = 0.f, s1 = 0.f;
#pragma unroll
    for (int j = 0; j < 4; ++j) { s0 += (v0[j].x * v0[j].x + v0[j].y * v0[j].y) + (v0[j].z * v0[j].z + v0[j].w * v0[j].w); s1 += (v1[j].x * v1[j].x + v1[j].y * v1[j].y) + (v1[j].z * v1[j].z + v1[j].w * v1[j].w); }
#pragma unroll
    for (int o = 1; o < 64; o <<= 1) { s0 += __shfl_xor(s0, o); s1 += __shfl_xor(s1, o); }
    const float r0 = rsqrtf(s0 * (1.f / DM) + EPS), r1 = rsqrtf(s1 * (1.f / DM) + EPS);
#pragma unroll
    for (int j = 0; j < 4; ++j) { const f32x4 wv = *(const f32x4*)(w + 4 * lane + 256 * j); v0[j] = v0[j] * r0 * wv; v1[j] = v1[j] * r1 * wv;
        u32x2 o; o.x = pk2(v0[j].x, v0[j].y); o.y = pk2(v0[j].z, v0[j].w); *(u32x2*)(orow0 + 4 * lane + 256 * j) = o;
        u32x2 p; p.x = pk2(v1[j].x, v1[j].y); p.y = pk2(v1[j].z, v1[j].w); *(u32x2*)(orow1 + 4 * lane + 256 * j) = p; }
    float g[32];
#pragma unroll
    for (int gi = 0; gi < 16; ++gi) { float a = 0.f, b = 0.f;
#pragma unroll
        for (int j = 0; j < 4; ++j) { const f32x4 ww = *(const LAS f32x4*)(wg + gi * 1024 + 4 * lane + 256 * j);
            a += (v0[j].x * ww.x + v0[j].y * ww.y) + (v0[j].z * ww.z + v0[j].w * ww.w); b += (v1[j].x * ww.x + v1[j].y * ww.y) + (v1[j].z * ww.z + v1[j].w * ww.w); }
        g[gi] = a; g[16 + gi] = b; }
#pragma unroll
    for (int i = 0; i < 16; ++i) { const bool up = lane & 1; const float send = up ? g[i] : g[i + 16], keep = up ? g[i + 16] : g[i]; g[i] = keep + __shfl_xor(send, 1); }
#pragma unroll
    for (int i = 0; i < 8; ++i) { const bool up = lane & 2; const float send = up ? g[i] : g[i + 8], keep = up ? g[i + 8] : g[i]; g[i] = keep + __shfl_xor(send, 2); }
#pragma unroll
    for (int i = 0; i < 4; ++i) { const bool up = lane & 4; const float send = up ? g[i] : g[i + 4], keep = up ? g[i + 4] : g[i]; g[i] = keep + __shfl_xor(send, 4); }
#pragma unroll
    for (int i = 0; i < 2; ++i) { const bool up = lane & 8; const float send = up ? g[i] : g[i + 2], keep = up ? g[i + 2] : g[i]; g[i] = keep + __shfl_xor(send, 8); }
    { const bool up = lane & 16; const float send = up ? g[0] : g[1], keep = up ? g[1] : g[0]; g[0] = keep + __shfl_xor(send, 16); }
    g[0] += __shfl_xor(g[0], 32);
    const int idx = ((lane & 1) << 4) | ((lane & 2) << 2) | (lane & 4) | ((lane & 8) >> 2) | ((lane & 16) >> 4);
    if (lane < 32) ((idx & 16) ? grow1 : grow0)[idx & 15] = g[0];
}
DI void transpose_matrix(const float* src, int ld, int K, int N, bf16_t* dst, LAS float* scr, int& cursor, int gw, int NGW, int lane, const float* ksc = nullptr) {
    const int nkb = K / 64, nnb = N / 32, items = nkb * nnb;
    int first = (gw - cursor % NGW + NGW) % NGW;
    for (int it = first; it < items; it += NGW) { const int kb = it / nnb, nb = it % nnb; transpose_item(src, ld, dst, K, scr, kb * 64, nb * 32, lane, ksc); }
    cursor += items;
}

DI void phase0(const Params& P, LAS unsigned char* lds) {
    const int tid = get_tid(), lane = tid & 63, wave = tid >> 6, gw = blockIdx.x * 8 + wave, NGW = gridDim.x * 8;
    LAS float* wg = (LAS float*)lds;
    LAS float* scr = (LAS float*)(lds + 65536 + wave * 8448);
    for (int i = tid; i < 16 * 1024; i += 512) { const int g = i >> 10, k = i & 1023; const int col = g < 8 ? 2048 + g : 4104 + (g - 8); wg[i] = P.w_in[(size_t)k * INC + col]; }
    __syncthreads();
    bf16_t* WS = (bf16_t*)P.ws;
    { float* q1 = (float*)(P.ws + W_SQ1); float* q2 = (float*)(P.ws + W_SQ2); for (int i = blockIdx.x * 512 + tid; i < NTOK; i += gridDim.x * 512) { q1[i] = 0.f; q2[i] = 0.f; } }
    { bf16_t* XN = (bf16_t*)(P.ws + W_XN); bf16_t* XBSp = (bf16_t*)(P.ws + W_XBS); float* GT = (float*)(P.ws + W_GATES);
      f32x4 v[4], v2[4], nv[4], nv2[4];
      load_row(v, P.x_prompt + (size_t)gw * DM, lane); load_row(v2, P.x_prompt + (size_t)(gw + NGW) * DM, lane);
      for (int r = gw; r < NTOK; r += 2 * NGW) { const int r2 = r + NGW, rn = r + 2 * NGW, rn2 = r + 3 * NGW;
          if (rn < NTOK) load_row(nv, rn < NP ? P.x_prompt + (size_t)rn * DM : P.x_sample + (size_t)(rn - NP) * DM, lane);
          if (rn2 < NTOK) load_row(nv2, rn2 < NP ? P.x_prompt + (size_t)rn2 * DM : P.x_sample + (size_t)(rn2 - NP) * DM, lane);
          bf16_t* o1 = r < NP ? XN + (size_t)r * DM : XBSp + (size_t)(r - NP) * DM; bf16_t* o2 = r2 < NP ? XN + (size_t)r2 * DM : XBSp + (size_t)(r2 - NP) * DM;
          if (r2 < NTOK) norm_row2_gates(v, v2, P.norm_mix_w, o1, o2, GT + (size_t)r * 16, GT + (size_t)r2 * 16, wg, lane);
          else norm_row<true>(v, P.norm_mix_w, o1, GT + (size_t)r * 16, wg, lane);
#pragma unroll
          for (int j = 0; j < 4; ++j) { v[j] = nv[j]; v2[j] = nv2[j]; } }
      bf16_t* MN = (bf16_t*)(P.ws + W_MN);
      load_row(v, P.mem_prompt + (size_t)gw * DM, lane);
      for (int r = gw; r < 4096; r += NGW) { const int rn = r + NGW;
          if (rn < 4096) load_row(nv, P.mem_prompt + (size_t)rn * DM, lane);
          norm_row<false>(v, P.norm_mem_w, MN + (size_t)r * DM, nullptr, wg, lane);
#pragma unroll
          for (int j = 0; j < 4; ++j) v[j] = nv[j]; } }
    int cur = 0;
    transpose_matrix(P.w_in, INC, DM, 2048, (bf16_t*)(P.ws + W_IN), scr, cur, gw, NGW, lane);
    transpose_matrix(P.w_in + 2056, INC, DM, 2048, (bf16_t*)(P.ws + W_IN) + (size_t)2048 * DM, scr, cur, gw, NGW, lane);
    transpose_matrix(P.wk, DM, DM, DM, (bf16_t*)(P.ws + W_K), scr, cur, gw, NGW, lane);
    transpose_matrix(P.wv, DM, DM, DM, (bf16_t*)(P.ws + W_V), scr, cur, gw, NGW, lane);
    (void)WS;
}

DI int swz72(int d, int t) { return d * 72 + ((((t >> 3) ^ (d >> 3)) & 7) << 3) + (t & 7); }
template <int K, bool SA, bool SB> DI f32x4 mm16s(const LAS bf16_t* A, int rowA0, const LAS bf16_t* B, int rowB0, f32x4 acc, int lane) {
    const int ra = rowA0 + (lane & 15), rb = rowB0 + (lane & 15), q = lane >> 4, ga = SA ? (ra >> 3) & 7 : 0, gb = SB ? (rb >> 3) & 7 : 0;
#pragma unroll
    for (int ks = 0; ks < K / 32; ++ks) {
        const bf16x8 a = *(const LAS bf16x8*)(A + ra * 72 + (((4 * ks + q) ^ ga) << 3)), b = *(const LAS bf16x8*)(B + rb * 72 + (((4 * ks + q) ^ gb) << 3));
        acc = __builtin_amdgcn_mfma_f32_16x16x32_bf16(a, b, acc, 0, 0, 0);
    }
    return acc;
}

DI void ldfr128(bf16x8 (&f)[4], const LAS bf16_t* base, int ld, int lane) {
    const LAS bf16_t* p = base + (lane & 15) * ld + (lane >> 4) * 8;
#pragma unroll
    for (int k = 0; k < 4; ++k) f[k] = *(const LAS bf16x8*)(p + 32 * k);
}
template <bool SW> DI void ldfr64(bf16x8 (&f)[2], const LAS bf16_t* img, int row0, int lane) {
    const int r = row0 + (lane & 15), q = lane >> 4, g = SW ? (r >> 3) & 7 : 0;
#pragma unroll
    for (int ks = 0; ks < 2; ++ks) f[ks] = *(const LAS bf16x8*)(img + r * 72 + (((4 * ks + q) ^ g) << 3));
}
DI f32x4 mma4(const bf16x8 (&a)[4], const bf16x8 (&b)[4], f32x4 acc) {
#pragma unroll
    for (int k = 0; k < 4; ++k) acc = __builtin_amdgcn_mfma_f32_16x16x32_bf16(a[k], b[k], acc, 0, 0, 0);
    return acc;
}
DI f32x4 mma2(const bf16x8 (&a)[2], const bf16x8 (&b)[2], f32x4 acc) {
#pragma unroll
    for (int k = 0; k < 2; ++k) acc = __builtin_amdgcn_mfma_f32_16x16x32_bf16(a[k], b[k], acc, 0, 0, 0);
    return acc;
}

DI void phase_conv(const Params& P, LAS unsigned char* lds, int row_lo, int nrows, unsigned gt, unsigned stride) {
    const int tid = get_tid();
    const bf16_t* PROJ = (const bf16_t*)(P.ws + W_PROJ); bf16_t* QC = (bf16_t*)(P.ws + W_QKVC);
    const float* cw = P.conv_w; const float* stc = P.st_conv;
    LAS float* cwl = (LAS float*)lds;
    for (int i = tid; i < 1536; i += 512) *(LAS f32x4*)(cwl + 4 * i) = *(const f32x4*)(cw + 4 * i);
    __syncthreads();
    const unsigned total = (unsigned)nrows * 192u;
    for (unsigned it0 = gt; it0 < total; it0 += 4u * stride) {
        u32x4 x4[4][4];
#pragma unroll
        for (int u = 0; u < 4; ++u) { const unsigned itu = it0 + u * stride, it = itu < total ? itu : it0;
            const int rrel = it / 192u, row = row_lo + rrel, cb = (it - rrel * 192u) * 8, tl = row < NP ? (row & (SEQ - 1)) : ((row - NP) & (TS - 1));
#pragma unroll
            for (int r = 0; r < 4; ++r) { const int back = 3 - r, rr = back <= tl ? row - back : row; x4[u][r] = *(const u32x4*)(PROJ + (size_t)rr * NMAIN + 2048 + cb); } }
#pragma unroll
        for (int u = 0; u < 4; ++u) { const unsigned it = it0 + u * stride;
            if (it < total) {
                const int rrel = it / 192u, row = row_lo + rrel, cg = it - rrel * 192u, cb = cg * 8, tl = row < NP ? (row & (SEQ - 1)) : ((row - NP) & (TS - 1));
                float y[8];
#pragma unroll
                for (int j = 0; j < 8; ++j) y[j] = 0.f;
#pragma unroll
                for (int r = 0; r < 4; ++r) { const LAS float* wp = cwl + r * 1536 + cb; const f32x4 w0 = *(const LAS f32x4*)wp, w1 = *(const LAS f32x4*)(wp + 4);
                    const float mk = (3 - r) <= tl ? 1.f : 0.f;
                    y[0] += mk * w0.x * bflo(x4[u][r][0]); y[1] += mk * w0.y * bfhi(x4[u][r][0]); y[2] += mk * w0.z * bflo(x4[u][r][1]); y[3] += mk * w0.w * bfhi(x4[u][r][1]);
                    y[4] += mk * w1.x * bflo(x4[u][r][2]); y[5] += mk * w1.y * bfhi(x4[u][r][2]); y[6] += mk * w1.z * bflo(x4[u][r][3]); y[7] += mk * w1.w * bfhi(x4[u][r][3]); }
                if (row >= NP && tl < 3) {
                    const int b = (row - NP) >> 4;
                    for (int r = 0; r < 3 - tl; ++r) { const int hist = tl + r;
                        const float* cp = stc + ((size_t)b * 3 + hist) * 1536 + cb; const float* wp = cw + r * 1536 + cb;
#pragma unroll
                        for (int j = 0; j < 8; ++j) y[j] += wp[j] * cp[j]; } }
#pragma unroll
                for (int j = 0; j < 8; ++j) y[j] = y[j] * sigmoidf_(y[j]);
                float ss = 0.f;
#pragma unroll
                for (int j = 0; j < 8; ++j) ss += y[j] * y[j];
                ss += __shfl_xor(ss, 1); ss += __shfl_xor(ss, 2); ss += __shfl_xor(ss, 4); ss += __shfl_xor(ss, 8);
                const float rn = cg < 128 ? rsqrtf(ss + EPS) : 1.f;
                u32x4 o; o.x = pk2(y[0] * rn, y[1] * rn); o.y = pk2(y[2] * rn, y[3] * rn); o.z = pk2(y[4] * rn, y[5] * rn); o.w = pk2(y[6] * rn, y[7] * rn);
                *(u32x4*)(QC + (size_t)row * 1536 + cb) = o; } }
    }
    __syncthreads();
}

DI void mlstm_seq(const Params& P, LAS unsigned char* lds, int b, int h, bool sample) {
    const int tid = get_tid(), lane = tid & 63, w = tid >> 6;
    LAS bf16_t* Qs = (LAS bf16_t*)(lds + 0);
    LAS bf16_t* Ks = (LAS bf16_t*)(lds + 17408);
    LAS bf16_t* Vt = (LAS bf16_t*)(lds + 34816);
    LAS bf16_t* Kwt = (LAS bf16_t*)(lds + 53248);
    LAS bf16_t* C0t = (LAS bf16_t*)(lds + 71680);
    LAS bf16_t* Sm = (LAS bf16_t*)(lds + 106496);
    LAS float* Hf = (LAS float*)(lds + 115712);
    LAS float* sm = (LAS float*)(lds + 149504);
    LAS float *sm_a = sm, *sm_bm = sm + 64, *sm_wi = sm + 128, *sm_ws = sm + 192, *sm_en = sm + 256, *sm_qn = sm + 320, *sm_rs = sm + 384  ,
              *sm_n0 = sm + 640  , *sm_np = sm + 768  , *sm_misc = sm + 1280, *sm_nw = sm + 1288  ;
    const bf16_t* PROJ = (const bf16_t*)(P.ws + W_PROJ); const float* GT = (const float*)(P.ws + W_GATES); bf16_t* HC = (bf16_t*)(P.ws + W_HCAT);
    const int row0 = sample ? NP + b * TS : b * SEQ, nchunks = sample ? 1 : 64, valid = sample ? TS : 64, bh = b * 4 + h;
    const float igb = P.ig_b[h], fgb = P.fg_b[h];
    const int lt = tid >> 4, lch = tid & 15;
    const int nt = tid >> 3, npart = tid & 7;
    f32x4 accs[8]; float m0 = 0.f;
    if (tid < 128) sm_nw[tid] = P.mlstm_norm_w[tid];
    if (sample) { const float* C0 = P.st_C + (size_t)bh * 16384;
#pragma unroll
        for (int j = 0; j < 8; ++j)
#pragma unroll
            for (int r = 0; r < 4; ++r) accs[j][r] = C0[(j * 16 + (lane >> 4) * 4 + r) * 128 + w * 16 + (lane & 15)];
        if (tid < 128) sm_n0[tid] = P.st_n[bh * 128 + tid];
        m0 = P.st_m[bh];
    } else {
#pragma unroll
        for (int j = 0; j < 8; ++j) accs[j] = (f32x4){0.f, 0.f, 0.f, 0.f};
        if (tid < 128) sm_n0[tid] = 0.f;
    }
#pragma unroll
    for (int j = 0; j < 8; ++j) *(LAS s16x4*)(C0t + (w * 16 + (lane & 15)) * 136 + j * 16 + (lane >> 4) * 4) = pack4(accs[j]);
    u32x4 nq[2], nk[2], nv[2], noa0, noa1; float ng0 = 0.f, ng1 = 0.f;
    const u32x4 Z4 = (u32x4){0u, 0u, 0u, 0u};
#define ML_ISSUE_QKV(cc) do { const int r0n_ = row0 + (cc) * 64; _Pragma("unroll") for (int e = 0; e < 2; ++e) { const int t = lt + 32 * e; nq[e] = Z4; nk[e] = Z4; nv[e] = Z4; \
        if (t < valid) { const bf16_t* pr = PROJ + (size_t)(r0n_ + t) * NMAIN + h * 128 + lch * 8; nq[e] = *(const u32x4*)pr; nk[e] = *(const u32x4*)(pr + 512); nv[e] = *(const u32x4*)(pr + 1024); } } \
        if (w == 0 && lane < valid) { const float* gr = GT + (size_t)(r0n_ + lane) * 16; ng0 = gr[h]; ng1 = gr[4 + h]; } } while (0)
#define ML_ISSUE_OA(cc) do { noa0 = Z4; noa1 = Z4; if (nt < valid) { const bf16_t* oa = PROJ + (size_t)(row0 + (cc) * 64 + nt) * NMAIN + 1536 + h * 128 + npart * 16; noa0 = *(const u32x4*)oa; noa1 = *(const u32x4*)(oa + 8); } } while (0)
    ML_ISSUE_QKV(0); ML_ISSUE_OA(0);
    lds_barrier();
    for (int c = 0; c < nchunks; ++c) {
        const int r0 = row0 + c * 64;
        if (w == 0) {
            const int t = lane; float ig = -INFINITY, lf = 0.f;
            if (t < valid) { ig = ng0 + igb; const float f = ng1 + fgb; lf = fminf(f, 0.f) - __logf(1.f + __expf(-fabsf(f))); }
            float bc = lf;
#pragma unroll
            for (int o = 1; o < 64; o <<= 1) { const float u = __shfl_up(bc, o); if (lane >= o) bc += u; }
            const float a = ig - bc; float pm = a;
#pragma unroll
            for (int o = 1; o < 64; o <<= 1) { const float u = __shfl_up(pm, o); if (lane >= o) pm = fmaxf(pm, u); }
            const float mt = bc + fmaxf(m0, pm);
            const float blast = __shfl(bc, 63), mlast = __shfl(mt, 63);
            sm_a[t] = a; sm_bm[t] = bc - mt; sm_wi[t] = __expf(bc + m0 - mt); sm_ws[t] = __expf(blast + a - mlast) * SCALE_H; sm_en[t] = __expf(-mt);
            if (lane == 0) { sm_misc[0] = __expf(blast + m0 - mlast); sm_misc[1] = mlast; }
        }
        lds_barrier();
#pragma unroll
        for (int e = 0; e < 2; ++e) { const int t = lt + 32 * e, ch = lch; const u32x4 q4 = nq[e], k4 = nk[e], v4 = nv[e];
            *(LAS u32x4*)(Qs + t * 136 + ch * 8) = q4; *(LAS u32x4*)(Ks + t * 136 + ch * 8) = k4;
            const float wsv = sm_ws[t];
#pragma unroll
            for (int j = 0; j < 4; ++j) { const unsigned ku = k4[j], vu = v4[j];
                Kwt[swz72(ch * 8 + 2 * j, t)] = f2bf(bflo(ku) * wsv); Kwt[swz72(ch * 8 + 2 * j + 1, t)] = f2bf(bfhi(ku) * wsv);
                Vt[swz72(ch * 8 + 2 * j, t)] = (bf16_t)(vu & 0xffffu); Vt[swz72(ch * 8 + 2 * j + 1, t)] = (bf16_t)(vu >> 16); } }
        if (c + 1 < nchunks) ML_ISSUE_QKV(c + 1);
        lds_barrier();
        { const int t = tid >> 3, part = tid & 7; float s = 0.f;
#pragma unroll
          for (int j = 0; j < 16; ++j) s += bf2f(Qs[t * 136 + part * 16 + j]) * sm_n0[part * 16 + j];
          s += __shfl_xor(s, 1); s += __shfl_xor(s, 2); s += __shfl_xor(s, 4);
          if (part == 0) sm_qn[t] = s; }
        { const int dk = tid & 127, pq = tid >> 7; float s = 0.f;
#pragma unroll
          for (int j = 0; j < 16; ++j) { const int ss = pq * 16 + j; s += sm_ws[ss] * bf2f(Ks[ss * 136 + dk]); }
          sm_np[pq * 128 + dk] = s; }
        const int ti = w >> 1;
        { bf16x8 aq[4]; ldfr128(aq, Qs + ti * 16 * 136, 136, lane);
        float bmr[4];
#pragma unroll
        for (int r = 0; r < 4; ++r) bmr[r] = sm_bm[ti * 16 + (lane >> 4) * 4 + r];
#pragma unroll
        for (int e = 0; e < 2; ++e) { const int si = (w * 2 + e) & 3; f32x4 acc = (f32x4){0.f, 0.f, 0.f, 0.f};
            if (si <= ti) { bf16x8 bk[4]; ldfr128(bk, Ks + si * 16 * 136, 136, lane); acc = mma4(aq, bk, acc); }
            const int s = si * 16 + (lane & 15); const float as = sm_a[s]; float rs[4];
#pragma unroll
            for (int r = 0; r < 4; ++r) { const int t = ti * 16 + (lane >> 4) * 4 + r; const float val = (s <= t) ? acc[r] * SCALE_H * __expf(bmr[r] + as) : 0.f; Sm[t * 72 + s] = f2bf(val); rs[r] = val; }
#pragma unroll
            for (int r = 0; r < 4; ++r) { rs[r] += __shfl_xor(rs[r], 1); rs[r] += __shfl_xor(rs[r], 2); rs[r] += __shfl_xor(rs[r], 4); rs[r] += __shfl_xor(rs[r], 8); }
            if ((lane & 15) == 0) {
#pragma unroll
                for (int r = 0; r < 4; ++r) sm_rs[si * 64 + ti * 16 + (lane >> 4) * 4 + r] = rs[r]; } } }
        lds_barrier();
        { bf16x8 aq[4]; ldfr128(aq, Qs + ti * 16 * 136, 136, lane); bf16x8 asc[2]; ldfr64<false>(asc, Sm, ti * 16, lane);
          float wir[4], invd[4];
#pragma unroll
          for (int r = 0; r < 4; ++r) { const int t = ti * 16 + (lane >> 4) * 4 + r; wir[r] = sm_wi[t];
              const float den = wir[r] * sm_qn[t] + ((sm_rs[t] + sm_rs[64 + t]) + (sm_rs[128 + t] + sm_rs[192 + t]));
              invd[r] = 1.f / fmaxf(fabsf(den), sm_en[t]); }
#pragma unroll 2
          for (int e = 0; e < 4; ++e) { const int di = (w & 1) * 4 + e;
              bf16x8 bc[4]; ldfr128(bc, C0t + di * 16 * 136, 136, lane);
              bf16x8 bv[2]; ldfr64<true>(bv, Vt, di * 16, lane);
              f32x4 acc = mma4(aq, bc, (f32x4){0.f, 0.f, 0.f, 0.f});
#pragma unroll
              for (int r = 0; r < 4; ++r) acc[r] *= wir[r];
              acc = mma2(asc, bv, acc);
#pragma unroll
              for (int r = 0; r < 4; ++r) Hf[(ti * 16 + (lane >> 4) * 4 + r) * 132 + di * 16 + (lane & 15)] = acc[r] * invd[r]; } }
        lds_barrier();
        { const int t = nt, part = npart; float hv[16]; float ss = 0.f;
#pragma unroll
          for (int j = 0; j < 4; ++j) { const f32x4 x = *(const LAS f32x4*)(Hf + t * 132 + part * 16 + 4 * j); hv[4 * j] = x.x; hv[4 * j + 1] = x.y; hv[4 * j + 2] = x.z; hv[4 * j + 3] = x.w; ss += (x.x * x.x + x.y * x.y) + (x.z * x.z + x.w * x.w); }
          ss += __shfl_xor(ss, 1); ss += __shfl_xor(ss, 2); ss += __shfl_xor(ss, 4);
          const float rs = rsqrtf(ss * (1.f / 128.f) + EPS);
          if (t < valid) { const u32x4 o0 = noa0, o1 = noa1; const LAS float* nw = sm_nw + part * 16; u32x4 r0v, r1v;
#pragma unroll
              for (int j = 0; j < 4; ++j) { const float a0 = hv[2 * j] * rs * nw[2 * j] * sigmoidf_(bflo(o0[j])), a1 = hv[2 * j + 1] * rs * nw[2 * j + 1] * sigmoidf_(bfhi(o0[j])); r0v[j] = pk2(a0, a1);
                  const float b0 = hv[8 + 2 * j] * rs * nw[8 + 2 * j] * sigmoidf_(bflo(o1[j])), b1 = hv[9 + 2 * j] * rs * nw[9 + 2 * j] * sigmoidf_(bfhi(o1[j])); r1v[j] = pk2(b0, b1); }
              bf16_t* op = HC + (size_t)(r0 + t) * DM + h * 128 + part * 16; *(u32x4*)op = r0v; *(u32x4*)(op + 8) = r1v; }
          if (c + 1 < nchunks) ML_ISSUE_OA(c + 1); }
        { const float d0 = sm_misc[0];
          bf16x8 bvw[2]; ldfr64<true>(bvw, Vt, w * 16, lane);
#pragma unroll
          for (int j = 0; j < 8; ++j) { accs[j] = accs[j] * d0; bf16x8 ak[2]; ldfr64<true>(ak, Kwt, j * 16, lane); accs[j] = mma2(ak, bvw, accs[j]);
              *(LAS s16x4*)(C0t + (w * 16 + (lane & 15)) * 136 + j * 16 + (lane >> 4) * 4) = pack4(accs[j]); }
          if (tid < 128) sm_n0[tid] = d0 * sm_n0[tid] + ((sm_np[tid] + sm_np[128 + tid]) + (sm_np[256 + tid] + sm_np[384 + tid]));
          m0 = sm_misc[1]; }
        lds_barrier();
    }
#undef ML_ISSUE_QKV
#undef ML_ISSUE_OA
    { float* Co = P.out + (sample ? O_SC : O_PC) + (size_t)bh * 16384;
#pragma unroll
      for (int j = 0; j < 8; ++j)
#pragma unroll
          for (int r = 0; r < 4; ++r) Co[(j * 16 + (lane >> 4) * 4 + r) * 128 + w * 16 + (lane & 15)] = accs[j][r];
      if (tid < 128) P.out[(sample ? O_SN : O_PN) + bh * 128 + tid] = sm_n0[tid];
      if (tid == 0) P.out[(sample ? O_SM : O_PM) + bh] = m0; }
    lds_barrier();
}

DI void gdn_s2(const LAS bf16_t* __restrict__ Qs, const LAS bf16_t* __restrict__ Ks, LAS bf16_t* __restrict__ Am, LAS bf16_t* __restrict__ QKd, LAS float* __restrict__ Adg,
               const LAS float* __restrict__ sm_G, const LAS float* __restrict__ sm_beta, int w, int lane) {
    const int kind = w >> 2, ti = w & 3; bf16x8 afr[4]; ldfr128(afr, (kind ? Qs : Ks) + ti * 16 * 136, 136, lane);
    float Gt[4], bt[4];
#pragma unroll
    for (int r = 0; r < 4; ++r) { const int t = ti * 16 + (lane >> 4) * 4 + r; Gt[r] = sm_G[t]; bt[r] = sm_beta[t]; }
#pragma unroll 2
    for (int si = 0; si < 4; ++si) { f32x4 acc = (f32x4){0.f, 0.f, 0.f, 0.f};
        if (si <= ti) { bf16x8 bk[4]; ldfr128(bk, Ks + si * 16 * 136, 136, lane); acc = mma4(afr, bk, acc); }
        const int s = si * 16 + (lane & 15); const float Gs = sm_G[s];
#pragma unroll
        for (int r = 0; r < 4; ++r) { const int t = ti * 16 + (lane >> 4) * 4 + r; const float dec = (s <= t) ? __expf(Gt[r] - Gs) : 0.f;
            if (kind == 0) { const float val = (s < t) ? bt[r] * dec * acc[r] : 0.f;
                if (ti == si) { Adg[ti * 320 + (t & 15) * 20 + (s & 15)] = val; Am[t * 72 + s] = 0; } else Am[t * 72 + s] = f2bf(val); }
            else QKd[t * 72 + s] = f2bf(SCALE_H * dec * acc[r]); } }
}

DI void gdn_seq(const Params& P, LAS unsigned char* lds, int b, int h, bool sample) {
    const int tid = get_tid(), lane = tid & 63, w = tid >> 6;
    LAS bf16_t* Qs = (LAS bf16_t*)(lds + 0);
    LAS bf16_t* Ks = (LAS bf16_t*)(lds + 17408);
    LAS bf16_t* Kdt = (LAS bf16_t*)(lds + 35840);
    LAS bf16_t* S0t = (LAS bf16_t*)(lds + 54272);
    LAS bf16_t* QKd = (LAS bf16_t*)(lds + 89088);
    LAS bf16_t* Am = (LAS bf16_t*)(lds + 98304);
    LAS bf16_t* Db = (LAS bf16_t*)(lds + 107520);
    LAS float* Adg = (LAS float*)(lds + 111872);
    LAS float* Rf = (LAS float*)(lds + 116992);
    LAS float* sm = (LAS float*)(lds + 150784);
    LAS float *sm_G = sm, *sm_gam = sm + 64, *sm_beta = sm + 128, *sm_bg = sm + 192, *sm_kd = sm + 256, *sm_misc = sm + 320, *sm_nw = sm + 328  ;
    const bf16_t* PROJ = (const bf16_t*)(P.ws + W_PROJ); const bf16_t* QC = (const bf16_t*)(P.ws + W_QKVC); const float* GT = (const float*)(P.ws + W_GATES); bf16_t* HC = (bf16_t*)(P.ws + W_HCAT);
    const int row0 = sample ? NP + b * TS : b * SEQ, nchunks = sample ? 1 : 64, valid = sample ? TS : 64, bh = b * 4 + h;
    const float Aexp = expf(P.A_log[h]), dtb = P.dt_bias[h];
    const int lt = tid >> 4, lch = tid & 15, nt = tid >> 3, npart = tid & 7;
    f32x4 accs[8];
    if (tid < 128) sm_nw[tid] = P.gdn_norm_w[tid];
    if (sample) { const float* S0 = P.st_S + (size_t)bh * 16384;
#pragma unroll
        for (int j = 0; j < 8; ++j)
#pragma unroll
            for (int r = 0; r < 4; ++r) accs[j][r] = S0[(j * 16 + (lane >> 4) * 4 + r) * 128 + w * 16 + (lane & 15)];
    } else {
#pragma unroll
        for (int j = 0; j < 8; ++j) accs[j] = (f32x4){0.f, 0.f, 0.f, 0.f};
    }
#pragma unroll
    for (int j = 0; j < 8; ++j) *(LAS s16x4*)(S0t + (w * 16 + (lane & 15)) * 136 + j * 16 + (lane >> 4) * 4) = pack4(accs[j]);
    u32x4 nq[2], nk[2], nv[2], nz0, nz1; float ng0 = 0.f, ng1 = 0.f;
    const u32x4 Z4 = (u32x4){0u, 0u, 0u, 0u};
#define GD_ISSUE_QKV(cc) do { const int r0n_ = row0 + (cc) * 64; _Pragma("unroll") for (int e = 0; e < 2; ++e) { const int t = 2 * lt + e; nq[e] = Z4; nk[e] = Z4; nv[e] = Z4; \
        if (t < valid) { const bf16_t* pr = QC + (size_t)(r0n_ + t) * 1536 + h * 128 + lch * 8; nq[e] = *(const u32x4*)pr; nk[e] = *(const u32x4*)(pr + 512); nv[e] = *(const u32x4*)(pr + 1024); } } \
        if (w == 0 && lane < valid) { const float* gr = GT + (size_t)(r0n_ + lane) * 16; ng0 = gr[8 + h]; ng1 = gr[12 + h]; } } while (0)
#define GD_ISSUE_Z(cc) do { nz0 = Z4; nz1 = Z4; if (nt < valid) { const bf16_t* zp = PROJ + (size_t)(row0 + (cc) * 64 + nt) * NMAIN + 3584 + h * 128 + npart * 16; nz0 = *(const u32x4*)zp; nz1 = *(const u32x4*)(zp + 8); } } while (0)
    GD_ISSUE_QKV(0); GD_ISSUE_Z(0);
    lds_barrier();
    for (int c = 0; c < nchunks; ++c) {
        const int r0 = row0 + c * 64;
        if (w == 0) { const int t = lane; float g = 0.f, beta = 0.f;
            if (t < valid) { const float ab = ng0 + dtb; const float sp = fmaxf(ab, 0.f) + __logf(1.f + __expf(-fabsf(ab))); g = -Aexp * sp; beta = 1.f / (1.f + __expf(-ng1)); }
            float G = g;
#pragma unroll
            for (int o = 1; o < 64; o <<= 1) { const float u = __shfl_up(G, o); if (lane >= o) G += u; }
            const float Gl = __shfl(G, 63); const float eg = __expf(G);
            sm_G[t] = G; sm_gam[t] = eg; sm_beta[t] = beta; sm_bg[t] = beta * eg; sm_kd[t] = __expf(Gl - G);
            if (lane == 0) sm_misc[0] = __expf(Gl); }
        lds_barrier();
        { const int ch = lch, t0 = 2 * lt;
          const float kd0 = sm_kd[t0], kd1 = sm_kd[t0 + 1];
#pragma unroll
          for (int e = 0; e < 2; ++e) { const int t = t0 + e; const u32x4 q4 = nq[e], k4 = nk[e], v4 = nv[e]; const float bt = sm_beta[t];
              *(LAS u32x4*)(Qs + t * 136 + ch * 8) = q4; *(LAS u32x4*)(Ks + t * 136 + ch * 8) = k4;
              f32x4 v0, v1; v0.x = bt * bflo(v4[0]); v0.y = bt * bfhi(v4[0]); v0.z = bt * bflo(v4[1]); v0.w = bt * bfhi(v4[1]); v1.x = bt * bflo(v4[2]); v1.y = bt * bfhi(v4[2]); v1.z = bt * bflo(v4[3]); v1.w = bt * bfhi(v4[3]);
              *(LAS f32x4*)(Rf + t * 132 + ch * 8) = v0; *(LAS f32x4*)(Rf + t * 132 + ch * 8 + 4) = v1; }
#pragma unroll
          for (int j = 0; j < 4; ++j) { const unsigned ka = nk[0][j], kb = nk[1][j];
              *(LAS unsigned*)(Kdt + swz72(ch * 8 + 2 * j, t0)) = pk2(bflo(ka) * kd0, bflo(kb) * kd1);
              *(LAS unsigned*)(Kdt + swz72(ch * 8 + 2 * j + 1, t0)) = pk2(bfhi(ka) * kd0, bfhi(kb) * kd1); } }
        if (c + 1 < nchunks) GD_ISSUE_QKV(c + 1);
        lds_barrier();
        gdn_s2(Qs, Ks, Am, QKd, Adg, sm_G, sm_beta, w, lane);
        lds_barrier();
        if (w == 0) { const int blk = lane >> 4, cc = lane & 15; const LAS float* Ab = Adg + blk * 320; float X[16];
#pragma unroll
            for (int r = 0; r < 16; ++r) { float s = (cc == r) ? 1.f : 0.f;
#pragma unroll
                for (int q4 = 0; q4 < (r + 3) / 4; ++q4) { const f32x4 av = *(const LAS f32x4*)(Ab + r * 20 + 4 * q4);
                    if (4 * q4 + 0 < r) s -= av.x * X[4 * q4 + 0];
                    if (4 * q4 + 1 < r) s -= av.y * X[4 * q4 + 1];
                    if (4 * q4 + 2 < r) s -= av.z * X[4 * q4 + 2];
                    if (4 * q4 + 3 < r) s -= av.w * X[4 * q4 + 3]; }
                X[r] = s; }
#pragma unroll
            for (int r = 0; r < 16; ++r) Db[blk * 384 + r * 24 + cc] = f2bf(X[r]); }
        f32x4 rhs[4]; bf16x8 bs[4]; ldfr128(bs, S0t + w * 16 * 136, 136, lane);
#pragma unroll
        for (int si = 0; si < 4; ++si) { bf16x8 ak[4]; ldfr128(ak, Ks + si * 16 * 136, 136, lane); const f32x4 acc = mma4(ak, bs, (f32x4){0.f, 0.f, 0.f, 0.f});
#pragma unroll
            for (int r = 0; r < 4; ++r) { const int sr = si * 16 + (lane >> 4) * 4 + r; rhs[si][r] = Rf[sr * 132 + w * 16 + (lane & 15)] - sm_bg[sr] * acc[r]; } }
        lds_barrier();
        s16x4 Wb[4];
#pragma unroll
        for (int i = 0; i < 4; ++i) { f32x4 pacc = (f32x4){0.f, 0.f, 0.f, 0.f};
#pragma unroll
            for (int j = 0; j < i; ++j) { const s16x4 af = *(const LAS s16x4*)(Am + (i * 16 + (lane & 15)) * 72 + j * 16 + (lane >> 4) * 4);
                pacc = __builtin_amdgcn_mfma_f32_16x16x16bf16_1k(af, Wb[j], pacc, 0, 0, 0); }
            const f32x4 rr = rhs[i] - pacc;
            const s16x4 df = *(const LAS s16x4*)(Db + i * 384 + (lane & 15) * 24 + (lane >> 4) * 4);
            const f32x4 wi = __builtin_amdgcn_mfma_f32_16x16x16bf16_1k(df, pack4(rr), (f32x4){0.f, 0.f, 0.f, 0.f}, 0, 0, 0);
            Wb[i] = pack4(wi); }
#pragma unroll
        for (int tp = 0; tp < 2; ++tp) { f32x4 ov[2]; float gv[2][4];
#pragma unroll
            for (int h2 = 0; h2 < 2; ++h2) { const int ti = 2 * tp + h2;
#pragma unroll
                for (int r = 0; r < 4; ++r) gv[h2][r] = sm_gam[ti * 16 + (lane >> 4) * 4 + r];
                bf16x8 aq[4]; ldfr128(aq, Qs + ti * 16 * 136, 136, lane); ov[h2] = mma4(aq, bs, (f32x4){0.f, 0.f, 0.f, 0.f}); }
#pragma unroll
            for (int h2 = 0; h2 < 2; ++h2) { const int ti = 2 * tp + h2;
#pragma unroll
                for (int r = 0; r < 4; ++r) ov[h2][r] *= SCALE_H * gv[h2][r];
#pragma unroll
                for (int j = 0; j <= ti; ++j) { const s16x4 af = *(const LAS s16x4*)(QKd + (ti * 16 + (lane & 15)) * 72 + j * 16 + (lane >> 4) * 4);
                    ov[h2] = __builtin_amdgcn_mfma_f32_16x16x16bf16_1k(af, Wb[j], ov[h2], 0, 0, 0); } }
#pragma unroll
            for (int h2 = 0; h2 < 2; ++h2) { const int ti = 2 * tp + h2;
#pragma unroll
                for (int r = 0; r < 4; ++r) Rf[(ti * 16 + (lane >> 4) * 4 + r) * 132 + w * 16 + (lane & 15)] = ov[h2][r]; } }
        { const float dG = sm_misc[0];
#pragma unroll
          for (int j = 0; j < 8; ++j) { accs[j] = accs[j] * dG; const int dk = j * 16 + (lane & 15), gsw = (dk >> 3) & 7;
#pragma unroll
              for (int i = 0; i < 4; ++i) { const s16x4 kf = *(const LAS s16x4*)(Kdt + dk * 72 + ((((2 * i + (lane >> 5)) ^ gsw) & 7) << 3) + ((lane >> 4) & 1) * 4);
                  accs[j] = __builtin_amdgcn_mfma_f32_16x16x16bf16_1k(kf, Wb[i], accs[j], 0, 0, 0); } } }
        lds_barrier();
        {
#pragma unroll
          for (int j = 0; j < 8; ++j) *(LAS s16x4*)(S0t + (w * 16 + (lane & 15)) * 136 + j * 16 + (lane >> 4) * 4) = pack4(accs[j]); }
        { const int t = nt, part = npart; float hv[16]; float ss = 0.f;
#pragma unroll
          for (int j = 0; j < 4; ++j) { const f32x4 x = *(const LAS f32x4*)(Rf + t * 132 + part * 16 + 4 * j); hv[4 * j] = x.x; hv[4 * j + 1] = x.y; hv[4 * j + 2] = x.z; hv[4 * j + 3] = x.w; ss += (x.x * x.x + x.y * x.y) + (x.z * x.z + x.w * x.w); }
          ss += __shfl_xor(ss, 1); ss += __shfl_xor(ss, 2); ss += __shfl_xor(ss, 4);
          const float rs = rsqrtf(ss * (1.f / 128.f) + EPS);
          if (t < valid) { const u32x4 o0 = nz0, o1 = nz1; const LAS float* nw = sm_nw + part * 16; u32x4 r0v, r1v;
#pragma unroll
              for (int j = 0; j < 4; ++j) { const float z0 = bflo(o0[j]), z1 = bfhi(o0[j]), z2 = bflo(o1[j]), z3 = bfhi(o1[j]);
                  const float a0 = hv[2 * j] * rs * nw[2 * j] * z0 * sigmoidf_(z0), a1 = hv[2 * j + 1] * rs * nw[2 * j + 1] * z1 * sigmoidf_(z1); r0v[j] = pk2(a0, a1);
                  const float b0 = hv[8 + 2 * j] * rs * nw[8 + 2 * j] * z2 * sigmoidf_(z2), b1 = hv[9 + 2 * j] * rs * nw[9 + 2 * j] * z3 * sigmoidf_(z3); r1v[j] = pk2(b0, b1); }
              bf16_t* op = HC + (size_t)(r0 + t) * DM + 512 + h * 128 + part * 16; *(u32x4*)op = r0v; *(u32x4*)(op + 8) = r1v; }
          if (c + 1 < nchunks) GD_ISSUE_Z(c + 1); }
        lds_barrier();
    }
#undef GD_ISSUE_QKV
#undef GD_ISSUE_Z
    { float* So = P.out + (sample ? O_SS : O_PS) + (size_t)bh * 16384;
#pragma unroll
      for (int j = 0; j < 8; ++j)
#pragma unroll
          for (int r = 0; r < 4; ++r) So[(j * 16 + (lane >> 4) * 4 + r) * 128 + w * 16 + (lane & 15)] = accs[j][r];
      const int rl = sample ? row0 + TS - 3 : row0 + SEQ - 3; float* co = P.out + (sample ? O_SCONV : O_PCONV) + (size_t)b * 3 * 1536;
      for (int i = tid; i < 3 * 384; i += 512) { const int j = i / 384, q = i % 384, which = q >> 7, d = q & 127, cb = which * 512 + h * 128 + d;
          co[j * 1536 + cb] = bf2f(PROJ[(size_t)(rl + j) * NMAIN + 2048 + cb]); } }
    lds_barrier();
}

DI void phase2(const Params& P, LAS unsigned char* lds, int skipkind) {
    const int wg = blockIdx.x, G = gridDim.x;
    { const int nit = wg < 128 ? 1 : 2;
      for (int k = 0; k < nit; ++k) { const bool sample = wg >= 128; const int s_ = wg - 128 + 128 * k;
          const int kind = sample ? (s_ >= 128) : (wg >= 64); const int loc = sample ? (s_ & 127) : (wg & 63);
          if (kind == skipkind) continue;
          if (kind == 0) mlstm_seq(P, lds, loc >> 2, loc & 3, sample); else gdn_seq(P, lds, loc >> 2, loc & 3, sample); } }
    if (wg >= 128 || G <= 128) { const int nw = G > 128 ? G - 128 : G, me = G > 128 ? wg - 128 : wg, tid = get_tid(), lane = tid & 63, wave = tid >> 6;
        const float* mk = P.out + O_PMK; const float* mv = P.out + O_PMV; bf16_t* KB = (bf16_t*)(P.ws + W_KBP); bf16_t* VT = (bf16_t*)(P.ws + W_VTP);
        const size_t n8 = (size_t)4096 * 1024 / 8;
        for (size_t i = (size_t)me * 512 + tid; i < n8; i += (size_t)nw * 512) { const f32x4 a = *(const f32x4*)(mk + i * 8), b = *(const f32x4*)(mk + i * 8 + 4);
            u32x4 o; o.x = pk2(a.x, a.y); o.y = pk2(a.z, a.w); o.z = pk2(b.x, b.y); o.w = pk2(b.z, b.w); *(u32x4*)(KB + i * 8) = o; }
        LAS float* scr = (LAS float*)(lds + wave * 8448);
        for (int it = me * 8 + wave; it < 64 * 32; it += nw * 8) { const int bh = it >> 5, sub = it & 31, b = bh >> 2, h = bh & 3, kb = sub >> 3, nb = sub & 7;
            transpose_item(mv + (size_t)b * 256 * 1024 + h * 256, 1024, VT + (size_t)bh * 65536, 256, scr, kb * 64, nb * 32, lane); }
        { const int gw2 = me * 8 + wave, NGW2 = nw * 8; int cur = 0;
          transpose_matrix(P.w_out, DM, DM, DM, (bf16_t*)(P.ws + W_OUT), scr, cur, gw2, NGW2, lane);
          transpose_matrix(P.wq, DM, DM, DM, (bf16_t*)(P.ws + W_Q), scr, cur, gw2, NGW2, lane, P.norm_x_w);
          transpose_matrix(P.wo, DM, DM, DM, (bf16_t*)(P.ws + W_O), scr, cur, gw2, NGW2, lane);
          transpose_matrix(P.w1, DFF, DM, DFF, (bf16_t*)(P.ws + W_1), scr, cur, gw2, NGW2, lane, P.norm_ffn_w);
          transpose_matrix(P.w2, DM, DFF, DM, (bf16_t*)(P.ws + W_2), scr, cur, gw2, NGW2, lane);
          bf16_t* VTs = (bf16_t*)(P.ws + W_VTS);
          for (int it = gw2; it < 128 * 32; it += NGW2) { const int bh = it >> 5, sub = it & 31, b = bh >> 2, h = bh & 3, kb = sub >> 3, nb = sub & 7;
              transpose_item(P.cache_v + (size_t)b * 256 * 1024 + h * 256, 1024, VTs + (size_t)bh * 65536, 256, scr, kb * 64, nb * 32, lane); }
          bf16_t* KBs = (bf16_t*)(P.ws + W_KBS); const size_t n8s = (size_t)32 * 256 * 1024 / 8; const float* ck = P.cache_k;
          for (size_t i = (size_t)me * 512 + tid; i < n8s; i += (size_t)nw * 512) { const f32x4 a = *(const f32x4*)(ck + i * 8), b = *(const f32x4*)(ck + i * 8 + 4);
              u32x4 o; o.x = pk2(a.x, a.y); o.y = pk2(a.z, a.w); o.z = pk2(b.x, b.y); o.w = pk2(b.z, b.w); *(u32x4*)(KBs + i * 8) = o; } }
    }
}

DI void phase_attn(const Params& P, LAS unsigned char* lds, int item_lo, int item_hi, int me, int nwg) {
    const int tid = get_tid(), lane = tid & 63, w = tid >> 6, q = lane >> 4, c = lane & 15;
    const bf16_t* QB = (const bf16_t*)(P.ws + W_PROJ);
    const bf16_t* QSb = (const bf16_t*)(P.ws + W_QS);
    bf16_t* ATT = (bf16_t*)(P.ws + W_HCAT);
    const int lr = tid >> 5, lc = (tid & 31) * 8;
    for (int item = item_lo + me; item < item_hi; item += nwg) {
        int b, h, r0, valid; const bf16_t *KB, *VT, *Qrow;
        if (item < 2048) { const int bh = item >> 5, tile = item & 31; b = bh >> 2; h = bh & 3; r0 = b * SEQ + tile * 128; valid = 128;
            KB = (const bf16_t*)(P.ws + W_KBP) + (size_t)b * 256 * 1024; VT = (const bf16_t*)(P.ws + W_VTP) + (size_t)bh * 65536; Qrow = QB + (size_t)r0 * DM; }
        else { const int bh = item - 2048; b = bh >> 2; h = bh & 3; r0 = NP + b * TS; valid = TS;
            KB = (const bf16_t*)(P.ws + W_KBS) + (size_t)b * 256 * 1024; VT = (const bf16_t*)(P.ws + W_VTS) + (size_t)bh * 65536; Qrow = QSb + (size_t)(b * TS) * DM; }
        const int t = w * 16 + c; const bool tv = t < valid;
        bf16x8 qf[8];
#pragma unroll
        for (int k8 = 0; k8 < 8; ++k8) { u32x4 x = (u32x4){0u, 0u, 0u, 0u}; if (tv) x = *(const u32x4*)(Qrow + (size_t)t * DM + h * 256 + k8 * 32 + q * 8); qf[k8] = __builtin_bit_cast(bf16x8, x); }
        u32x4 ra[4], rb[4];
#define AT_LOAD(ra, p) do { if ((p) < 4) { _Pragma("unroll") for (int e = 0; e < 4; ++e) ra[e] = *(const u32x4*)(KB + (size_t)((p) * 64 + lr + 16 * e) * 1024 + h * 256 + lc); } \
                        else { _Pragma("unroll") for (int e = 0; e < 4; ++e) ra[e] = *(const u32x4*)(VT + (size_t)(((p) - 4) * 64 + lr + 16 * e) * 256 + lc); } } while (0)
#define AT_PUT(ra, p) do { LAS bf16_t* dst_ = (LAS bf16_t*)(lds + ((p) & 1) * 33792); _Pragma("unroll") for (int e = 0; e < 4; ++e) *(LAS u32x4*)(dst_ + (lr + 16 * e) * 264 + lc) = ra[e]; } while (0)
        AT_LOAD(ra, 0); AT_LOAD(rb, 1); AT_PUT(ra, 0); AT_LOAD(ra, 2);
        lds_barrier();
        f32x4 sacc[16];
#pragma unroll
        for (int p = 0; p < 4; ++p) {
            if (p & 1) { AT_PUT(ra, p + 1); AT_LOAD(ra, p + 3); } else { AT_PUT(rb, p + 1); AT_LOAD(rb, p + 3); }
            const LAS bf16_t* buf = (const LAS bf16_t*)(lds + (p & 1) * 33792);
#pragma unroll
            for (int nt = 0; nt < 4; ++nt) { const LAS bf16_t* kp = buf + (nt * 16 + c) * 264 + q * 8; f32x4 acc = (f32x4){0.f, 0.f, 0.f, 0.f};
#pragma unroll
                for (int k8 = 0; k8 < 8; ++k8) acc = __builtin_amdgcn_mfma_f32_16x16x32_bf16(*(const LAS bf16x8*)(kp + k8 * 32), qf[k8], acc, 0, 0, 0);
                sacc[p * 4 + nt] = acc; }
            lds_barrier();
        }
        float mx = -INFINITY;
#pragma unroll
        for (int i = 0; i < 16; ++i) mx = fmaxf(mx, fmaxf(fmaxf(sacc[i][0], sacc[i][1]), fmaxf(sacc[i][2], sacc[i][3])));
        mx = fmaxf(mx, __shfl_xor(mx, 16)); mx = fmaxf(mx, __shfl_xor(mx, 32));
        float sum = 0.f;
#pragma unroll
        for (int i = 0; i < 16; ++i)
#pragma unroll
            for (int r = 0; r < 4; ++r) { const float e = __expf((sacc[i][r] - mx) * 0.0625f); sacc[i][r] = e; sum += e; }
        sum += __shfl_xor(sum, 16); sum += __shfl_xor(sum, 32);
        const float inv = 1.f / sum;
        bf16x8 pf[8];
#pragma unroll
        for (int j = 0; j < 8; ++j) { const s16x4 lo = pack4(sacc[2 * j] * inv), hi = pack4(sacc[2 * j + 1] * inv);
            pf[j] = (bf16x8){lo[0], lo[1], lo[2], lo[3], hi[0], hi[1], hi[2], hi[3]}; }
#pragma unroll
        for (int p = 4; p < 8; ++p) {
            if (p + 1 < 8) { if (p & 1) { AT_PUT(ra, p + 1); } else { AT_PUT(rb, p + 1); } }
            if (p + 3 < 8) { if (p & 1) { AT_LOAD(ra, p + 3); } else { AT_LOAD(rb, p + 3); } }
            const LAS bf16_t* buf = (const LAS bf16_t*)(lds + (p & 1) * 33792);
#pragma unroll
            for (int dt = 0; dt < 4; ++dt) { const LAS bf16_t* vp = buf + (dt * 16 + c) * 264 + q * 4; f32x4 acc = (f32x4){0.f, 0.f, 0.f, 0.f};
#pragma unroll
                for (int j = 0; j < 8; ++j) { const s16x4 lo = *(const LAS s16x4*)(vp + 32 * j), hi = *(const LAS s16x4*)(vp + 32 * j + 16);
                    const bf16x8 vf = (bf16x8){lo[0], lo[1], lo[2], lo[3], hi[0], hi[1], hi[2], hi[3]};
                    acc = __builtin_amdgcn_mfma_f32_16x16x32_bf16(vf, pf[j], acc, 0, 0, 0); }
                if (tv) *(s16x4*)(ATT + (size_t)(r0 + t) * DM + h * 256 + (p - 4) * 64 + dt * 16 + q * 4) = pack4(acc); }
            lds_barrier();
        }
#undef AT_LOAD
#undef AT_PUT
    }
}

DI void phase_norm(const Params& P, const float* w) {
    const int tid = get_tid(), lane = tid & 63, gw = blockIdx.x * 8 + (tid >> 6), NGW = gridDim.x * 8;
    bf16_t* XN = (bf16_t*)(P.ws + W_XN);
    f32x4 v[4], nv[4];
    load_row(v, P.out + (size_t)gw * DM, lane);
    for (int r = gw; r < NTOK; r += NGW) { const int rn = r + NGW;
        if (rn < NTOK) load_row(nv, P.out + (size_t)rn * DM, lane);
        norm_row<false>(v, w, XN + (size_t)r * DM, nullptr, nullptr, lane);
#pragma unroll
        for (int j = 0; j < 4; ++j) v[j] = nv[j]; }
}
DI void phase_final(const Params& P, const bf16_t* xb, float* y, int nrows, int gw, int NGW) {
    const int tid = get_tid(), lane = tid & 63;
    u32x4 v[2], nv[2];
    if (gw < nrows) { v[0] = *(const u32x4*)(xb + (size_t)gw * DM + 8 * lane); v[1] = *(const u32x4*)(xb + (size_t)gw * DM + 512 + 8 * lane); }
    f32x4 wv[4];
#pragma unroll
    for (int j = 0; j < 2; ++j) { wv[2 * j] = *(const f32x4*)(P.norm_final_w + 512 * j + 8 * lane); wv[2 * j + 1] = *(const f32x4*)(P.norm_final_w + 512 * j + 8 * lane + 4); }
    for (int r = gw; r < nrows; r += NGW) { const int rn = r + NGW;
        if (rn < nrows) { nv[0] = *(const u32x4*)(xb + (size_t)rn * DM + 8 * lane); nv[1] = *(const u32x4*)(xb + (size_t)rn * DM + 512 + 8 * lane); }
        f32x4 x[4]; float s = 0.f;
#pragma unroll
        for (int j = 0; j < 2; ++j) { x[2 * j] = (f32x4){bflo(v[j].x), bfhi(v[j].x), bflo(v[j].y), bfhi(v[j].y)}; x[2 * j + 1] = (f32x4){bflo(v[j].z), bfhi(v[j].z), bflo(v[j].w), bfhi(v[j].w)}; }
#pragma unroll
        for (int j = 0; j < 4; ++j) s += (x[j].x * x[j].x + x[j].y * x[j].y) + (x[j].z * x[j].z + x[j].w * x[j].w);
        const float rstd = rsqrtf(wave_sum(s) * (1.f / DM) + EPS);
        float* yr = y + (size_t)r * DM;
#pragma unroll
        for (int j = 0; j < 2; ++j) { *(f32x4*)(yr + 512 * j + 8 * lane) = x[2 * j] * rstd * wv[2 * j]; *(f32x4*)(yr + 512 * j + 8 * lane + 4) = x[2 * j + 1] * rstd * wv[2 * j + 1]; }
        v[0] = nv[0]; v[1] = nv[1]; }
}

DI void tree_barrier(unsigned* ctl, unsigned k, unsigned idx = 0xffffffffu, unsigned ngroups = 8u) {
    __builtin_amdgcn_fence(__ATOMIC_RELEASE, "workgroup");
    __builtin_amdgcn_s_barrier();
    if (threadIdx.x == 0) {
        __builtin_amdgcn_fence(__ATOMIC_ACQUIRE, "workgroup");
        __builtin_amdgcn_fence(__ATOMIC_RELEASE, "agent");
        if (idx == 0xffffffffu) idx = blockIdx.x;
        unsigned* grp = ctl + 64 * (idx % ngroups); unsigned* glob = ctl + 64 * 8; unsigned* gen = ctl + 64 * 9;
        const unsigned old = __hip_atomic_fetch_add(grp, 1u, __ATOMIC_RELAXED, __HIP_MEMORY_SCOPE_AGENT);
        if (old == 32u * k - 1u) { const unsigned old2 = __hip_atomic_fetch_add(glob, 1u, __ATOMIC_RELAXED, __HIP_MEMORY_SCOPE_AGENT);
            if (old2 == ngroups * k - 1u) __hip_atomic_store(gen, k, __ATOMIC_RELAXED, __HIP_MEMORY_SCOPE_AGENT); }
        unsigned polls = 0;
        while (__hip_atomic_load(gen, __ATOMIC_RELAXED, __HIP_MEMORY_SCOPE_AGENT) < k) { __builtin_amdgcn_s_sleep(1); if (++polls > 4000000u) break; }
        __builtin_amdgcn_fence(__ATOMIC_ACQUIRE, "agent");
        __builtin_amdgcn_fence(__ATOMIC_RELEASE, "workgroup");
    }
    __builtin_amdgcn_s_barrier();
    __builtin_amdgcn_fence(__ATOMIC_ACQUIRE, "workgroup");
}

DI void rstd_pass(const float* sq, float* rstd, int lo, int hi, int gt, int NT) {
    for (int r = lo + gt; r < hi; r += NT) { const f32x4* sp = (const f32x4*)(sq + (size_t)r * 16); const f32x4 a = sp[0], b = sp[1], c = sp[2], d = sp[3];
        const float tot = (((a.x + a.y) + (a.z + a.w)) + ((b.x + b.y) + (b.z + b.w))) + (((c.x + c.y) + (c.z + c.w)) + ((d.x + d.y) + (d.z + d.w)));
        rstd[r] = rsqrtf(tot * (1.f / DM) + EPS); }
}
DI void sample_pre(const Params& P, LAS unsigned char* lds, unsigned* ctl2, unsigned& k2) {
    const int me = blockIdx.x - 128; unsigned char* ws = P.ws; float* out = P.out;
    { EpiBf16<0, false> e; e.O = (bf16_t*)(ws + W_PROJ) + (size_t)NP * NMAIN; e.ldc = NMAIN; e.rstd = nullptr; run_gemm(lds, (const bf16_t*)(ws + W_XBS), (const bf16_t*)(ws + W_IN), NS, NMAIN, DM, e, 0, 128, me);
      EpiF32 ek; ek.C = out + O_PMK; ek.ldc = DM; run_gemm(lds, (const bf16_t*)(ws + W_MN), (const bf16_t*)(ws + W_K), 4096, DM, DM, ek, 32, 128, me);
      EpiF32 ev; ev.C = out + O_PMV; ev.ldc = DM; run_gemm(lds, (const bf16_t*)(ws + W_MN), (const bf16_t*)(ws + W_V), 4096, DM, DM, ev, 96, 128, me); }
    tree_barrier(ctl2, ++k2, me, 4);
    phase_conv(P, lds, NP, NS, (unsigned)(me * 512 + (int)threadIdx.x), 128u * 512u);
    tree_barrier(ctl2, ++k2, me, 4);
}
DI void sample_chain(const Params& P, LAS unsigned char* lds, unsigned* ctl2, unsigned& k2) {
    const int me = blockIdx.x - 128; unsigned char* ws = P.ws; float* Xs = P.out + (size_t)NP * DM;
    bf16_t* XBS = (bf16_t*)(ws + W_XBS); bf16_t* QS = (bf16_t*)(ws + W_QS); bf16_t* HS = (bf16_t*)(ws + W_HS); const bf16_t* HCs = (const bf16_t*)(ws + W_HCAT) + (size_t)NP * DM;
    float* sq1 = (float*)(ws + W_SQ1) + NP; float* sq2 = (float*)(ws + W_SQ2) + NP;
    tree_barrier(ctl2, ++k2, me, 4);
    { EpiResB<true> e; e.resF = P.x_sample; e.resB = nullptr; e.XB = XBS; e.sq = sq1; run_gemm(lds, HCs, (const bf16_t*)(ws + W_OUT), NS, DM, DM, e, 0, 128, me); }
    tree_barrier(ctl2, ++k2, me, 4);
    { EpiBf16<0, true> e; e.O = QS; e.ldc = DM; e.rstd = sq1; run_gemm(lds, XBS, (const bf16_t*)(ws + W_Q), NS, DM, DM, e, 0, 128, me); }
    tree_barrier(ctl2, ++k2, me, 4);
    phase_attn(P, lds, 2048, 2048 + 128, me, 128);
    tree_barrier(ctl2, ++k2, me, 4);
    { EpiResB<false> e; e.resF = nullptr; e.resB = XBS; e.XB = XBS; e.sq = sq2; run_gemm(lds, HCs, (const bf16_t*)(ws + W_O), NS, DM, DM, e, 0, 128, me); }
    tree_barrier(ctl2, ++k2, me, 4);
    { EpiBf16<1, true> e; e.O = HS; e.ldc = DFF; e.rstd = sq2; run_gemm(lds, XBS, (const bf16_t*)(ws + W_1), NS, DFF, DM, e, 0, 128, me); }
    tree_barrier(ctl2, ++k2, me, 4);
    { EpiResB<false> e; e.resF = nullptr; e.resB = XBS; e.XB = XBS; e.sq = nullptr; run_gemm(lds, HS, (const bf16_t*)(ws + W_2), NS, DM, DFF, e, 0, 128, me); }
    tree_barrier(ctl2, ++k2, me, 4);
    phase_final(P, XBS, Xs, NS, me * 8 + (int)(threadIdx.x >> 6), 1024);
}

__global__ __launch_bounds__(512, 2) void mega_fwd(Params P) {
    extern __shared__ __attribute__((aligned(16))) unsigned char shm[];
    LAS unsigned char* lds = (LAS unsigned char*)shm;
    cg::grid_group grid = cg::this_grid();
    unsigned char* ws = P.ws; float* out = P.out; unsigned* ctl = (unsigned*)(ws + W_CTL); unsigned bk = 0;
    phase0(P, lds);
#ifdef PROBE_P0X2
    grid.sync();
    phase0(P, lds);
#endif
    if (blockIdx.x == 0 && threadIdx.x == 0) { Params* t = (Params*)(ws + W_TAB); t->x_prompt = P.x_prompt; t->x_sample = P.x_sample; t->st_C = P.st_C; t->st_n = P.st_n; t->st_m = P.st_m; t->st_S = P.st_S; t->st_conv = P.st_conv; t->cache_k = P.cache_k; t->cache_v = P.cache_v; t->mem_prompt = P.mem_prompt; t->norm_mix_w = P.norm_mix_w; t->w_in = P.w_in; t->ig_b = P.ig_b; t->fg_b = P.fg_b; t->mlstm_norm_w = P.mlstm_norm_w; t->conv_w = P.conv_w; t->A_log = P.A_log; t->dt_bias = P.dt_bias; t->gdn_norm_w = P.gdn_norm_w; t->w_out = P.w_out; t->norm_x_w = P.norm_x_w; t->norm_mem_w = P.norm_mem_w; t->wq = P.wq; t->wk = P.wk; t->wv = P.wv; t->wo = P.wo; t->norm_ffn_w = P.norm_ffn_w; t->w1 = P.w1; t->w2 = P.w2; t->norm_final_w = P.norm_final_w; t->out = P.out; t->ws = P.ws; }
    if (blockIdx.x == 0) for (int i = threadIdx.x; i < 2048; i += 512) ctl[i] = 0u;
    grid.sync();
    const Params& T = *(const Params*)(ws + W_TAB);
    { EpiBf16<0, false> e; e.O = (bf16_t*)(ws + W_PROJ); e.ldc = NMAIN; e.rstd = nullptr;
      run_gemm(lds, (const bf16_t*)(ws + W_XN), (const bf16_t*)(ws + W_IN), NP, NMAIN, DM, e, 0); }
    tree_barrier(ctl, ++bk);
    phase_conv(T, lds, 0, NP, blockIdx.x * 512u + threadIdx.x, gridDim.x * 512u);
#ifdef PROBE_CONVX2
    tree_barrier(ctl, ++bk);
    phase_conv(T, lds);
#endif
    tree_barrier(ctl, ++bk);
    unsigned k2 = 0;
    if (blockIdx.x >= 128) sample_pre(T, lds, ctl + 1024, k2);
    phase2(T, lds, -1);
    if (blockIdx.x >= 128) sample_chain(T, lds, ctl + 1024, k2);
    tree_barrier(ctl, ++bk);
    { EpiResB<true> e; e.resF = T.x_prompt; e.resB = nullptr; e.XB = (bf16_t*)(ws + W_XN); e.sq = (float*)(ws + W_SQ1); run_gemm(lds, (const bf16_t*)(ws + W_HCAT), (const bf16_t*)(ws + W_OUT), NP, DM, DM, e, 0); }
    tree_barrier(ctl, ++bk);
    { EpiBf16<0, true> e; e.O = (bf16_t*)(ws + W_PROJ); e.ldc = DM; e.rstd = (const float*)(ws + W_SQ1); run_gemm(lds, (const bf16_t*)(ws + W_XN), (const bf16_t*)(ws + W_Q), NP, DM, DM, e, 0); }
    tree_barrier(ctl, ++bk);
    phase_attn(T, lds, 0, 2048, (int)blockIdx.x, (int)gridDim.x);
    tree_barrier(ctl, ++bk);
    { EpiResB<false> e; e.resF = nullptr; e.resB = (const bf16_t*)(ws + W_XN); e.XB = (bf16_t*)(ws + W_XN); e.sq = (float*)(ws + W_SQ2); run_gemm(lds, (const bf16_t*)(ws + W_HCAT), (const bf16_t*)(ws + W_O), NP, DM, DM, e, 0); }
    tree_barrier(ctl, ++bk);
    { EpiBf16<1, true> e; e.O = (bf16_t*)(ws + W_PROJ); e.ldc = DFF; e.rstd = (const float*)(ws + W_SQ2); run_gemm(lds, (const bf16_t*)(ws + W_XN), (const bf16_t*)(ws + W_1), NP, DFF, DM, e, 0); }
    tree_barrier(ctl, ++bk);
    { EpiResB<false> e; e.resF = nullptr; e.resB = (const bf16_t*)(ws + W_XN); e.XB = (bf16_t*)(ws + W_XN); e.sq = nullptr; run_gemm(lds, (const bf16_t*)(ws + W_PROJ), (const bf16_t*)(ws + W_2), NP, DM, DFF, e, 0); }
    tree_barrier(ctl, ++bk);
    phase_final(T, (const bf16_t*)(ws + W_XN), out, NP, (int)(blockIdx.x * 8 + (threadIdx.x >> 6)), (int)gridDim.x * 8);
#ifdef PROBE_SYNCX
    for (int i = 0; i < PROBE_SYNCX; ++i) tree_barrier(ctl, ++bk);
#endif
}

extern "C" void kernel_launch(void* const* d_in, const int* in_sizes, int n_in, void* d_out, int out_size, void* d_ws, size_t ws_size, hipStream_t stream) {
    static int grid_blocks = 0;
    if (grid_blocks == 0) {
        if (n_in != 30 || (size_t)out_size != O_END || ws_size < W_END) { fprintf(stderr, "kernel_launch: unexpected shapes: n_in %d out %d ws %zu (need %zu)\n", n_in, out_size, ws_size, (size_t)W_END); grid_blocks = -1; return; }
        int dev = 0, cus = 0, per_cu = 0;
        hipGetDevice(&dev);
        hipDeviceGetAttribute(&cus, hipDeviceAttributeMultiprocessorCount, dev);
        if (hipFuncSetAttribute((const void*)mega_fwd, hipFuncAttributeMaxDynamicSharedMemorySize, LDS_BYTES) != hipSuccess) { fprintf(stderr, "kernel_launch: hipFuncSetAttribute failed\n"); grid_blocks = -1; return; }
        if (hipOccupancyMaxActiveBlocksPerMultiprocessor(&per_cu, (const void*)mega_fwd, 512, LDS_BYTES) != hipSuccess || per_cu < 1) { fprintf(stderr, "kernel_launch: occupancy query gave %d\n", per_cu); (void)hipGetLastError(); grid_blocks = -1; return; }
        grid_blocks = cus * per_cu;
        if (grid_blocks != 256) { fprintf(stderr, "kernel_launch: expected 256 resident workgroups, got %d\n", grid_blocks); grid_blocks = -1; return; }
    }
    if (grid_blocks < 0) return;
    Params p{};
    const float* const* in = (const float* const*)d_in;
    p.x_prompt = in[0]; p.x_sample = in[1]; p.st_C = in[2]; p.st_n = in[3]; p.st_m = in[4]; p.st_S = in[5]; p.st_conv = in[6]; p.cache_k = in[7]; p.cache_v = in[8]; p.mem_prompt = in[9];
    p.norm_mix_w = in[10]; p.w_in = in[11]; p.ig_b = in[12]; p.fg_b = in[13]; p.mlstm_norm_w = in[14]; p.conv_w = in[15]; p.A_log = in[16]; p.dt_bias = in[17]; p.gdn_norm_w = in[18]; p.w_out = in[19];
    p.norm_x_w = in[20]; p.norm_mem_w = in[21]; p.wq = in[22]; p.wk = in[23]; p.wv = in[24]; p.wo = in[25]; p.norm_ffn_w = in[26]; p.w1 = in[27]; p.w2 = in[28]; p.norm_final_w = in[29];
    p.out = (float*)d_out; p.ws = (unsigned char*)d_ws;
    void* args[] = {&p};
    hipError_t e = hipLaunchCooperativeKernel((const void*)mega_fwd, dim3(grid_blocks), dim3(512), args, LDS_BYTES, stream);
    if (e != hipSuccess) fprintf(stderr, "cooperative launch failed: %s (grid %d)\n", hipGetErrorString(e), grid_blocks);
}
```

```cpp
#include <hip/hip_cooperative_groups.h>
#include <cstdio>
#include <cstdint>
#include <hip/hip_runtime.h>
namespace pg8 {
#define PG8_LAS __attribute__((address_space(3)))
typedef unsigned short bf16_t;
typedef short bf16x8 __attribute__((ext_vector_type(8)));
typedef float f32x4 __attribute__((ext_vector_type(4)));
typedef unsigned u32x4 __attribute__((ext_vector_type(4)));
constexpr int BM = 256, BK = 64, HALF = 128, HTB = HALF * BK * 2  , STAGE_BYTES = 8 * HTB, NXCD = 8, WGM = 8;

__host__ __device__ __forceinline__ int lds_byte(int r, int c) { const int st = (r >> 4) * 2 + (c >> 5), rr = r & 15, cc = c & 31, ob = rr * 64 + cc * 2; return st * 1024 + (ob ^ (((ob >> 9) & 1) << 5)); }
__host__ __device__ __forceinline__ void stage_rc(int b, int& R, int& C) { const int st = b / 1024, sb = b % 1024, swz = sb ^ (((sb >> 9) & 1) << 5); R = (st >> 1) * 16 + swz / 64; C = (st & 1) * 32 + (swz % 64) / 2; }
__host__ __device__ __forceinline__ int perm32(int rho) { const int n = rho >> 4, i = rho & 15; return 8 * (i >> 2) + 4 * n + (i & 3); }

struct Unit { int pm, pn; };
struct Gemm { const bf16_t* A; const bf16_t* Bt; int M, N, K; };

struct StaticOrder {
    int nM, nN, nwg, G, c;
    __host__ __device__ void init(int M, int N, int G_, int c_) { nM = M / BM; nN = N / BM; nwg = nM * nN; G = G_; c = c_; }
    __host__ __device__ bool next(int i, Unit& u) const {
        const long L = (long)i * G + c; if (L >= nwg) return false;
        int wgid = (int)L; { const int q = nwg / NXCD, r = nwg % NXCD, xcd = wgid % NXCD, off = wgid / NXCD; wgid = (xcd < r ? xcd * (q + 1) : r * (q + 1) + (xcd - r) * q) + off; }
        const int nig = WGM * nN, gid = wgid / nig, fm = gid * WGM, gsz = (nM - fm) < WGM ? (nM - fm) : WGM;
        u.pm = fm + ((wgid % nig) % gsz); u.pn = (wgid % nig) / gsz; return true;
    }
    __device__ __forceinline__ void a_ready(const Unit&) const {}
    __device__ __forceinline__ void done(const Unit&) const {}
};
__device__ __forceinline__ unsigned cvt_pk_bf16(float lo, float hi) { unsigned r; asm volatile("v_cvt_pk_bf16_f32 %0, %1, %2" : "=v"(r) : "v"(lo), "v"(hi)); return r; }

template <class Epi, class Sched, bool STAMP = false>
__device__ __forceinline__ void gemm_phase(PG8_LAS unsigned char* lds, const Gemm g, const Sched& S, const Epi& E, unsigned long long* stamps) {
    int tid_ = threadIdx.x; asm volatile("" : "+v"(tid_)); const int tid = tid_, wid = __builtin_amdgcn_readfirstlane(tid >> 6), lane = tid & 63, wr = wid >> 2, wc = wid & 3, fr = lane & 15, fq = lane >> 4;
    const int K = g.K, nt = K / BK;
    int ts_lo = 0, ts_hi = 0, nts = 0; const unsigned long long rt_entry = STAMP ? (unsigned long long)wall_clock64() : 0ull;
#define PG8_STAMP() do { if (STAMP && wid == 0 && nts < 64) { const unsigned long long _c = (unsigned long long)clock64(); \
        ts_lo = (lane == nts) ? (int)(unsigned)_c : ts_lo; ts_hi = (lane == nts) ? (int)(unsigned)(_c >> 32) : ts_hi; ++nts; } } while (0)
    PG8_STAMP();
    unsigned voffA[2], voffB[2];
#pragma unroll
    for (int i = 0; i < 2; ++i) { int R, C; stage_rc(tid * 16 + i * 8192, R, C); const int Rb = Epi::PERM ? ((R & ~31) + perm32(R & 31)) : R;
        voffA[i] = (unsigned)(R * K + C) * 2u; voffB[i] = (unsigned)(Rb * K + C) * 2u; }
    const size_t kstep = (size_t)(BK * 2);
    const size_t hstep = (size_t)HALF * K * 2;
    const size_t tstep = 2 * hstep;
    const unsigned ldsw = (unsigned)wid * 1024u;
    const int aoff = lds_byte(wr * 64 + fr, fq * 8), boff = lds_byte(wc * 32 + fr, fq * 8);
#define PG8_SA(b, h) (((b) * 2 + (h)) * HTB)
#define PG8_SB(b, h) ((4 + (b) * 2 + (h)) * HTB)
#define PG8_STAGE(bufoff, gbase, voff) do { _Pragma("unroll") for (int _i = 0; _i < 2; ++_i) \
        __builtin_amdgcn_global_load_lds((const unsigned*)((const char*)(gbase) + (voff)[_i]), (PG8_LAS unsigned*)(lds + (bufoff) + ldsw + _i * 8192), 16, 0, 0); } while (0)
#define PG8_LDA(dst, b, h) do { _Pragma("unroll") for (int m = 0; m < 4; ++m) _Pragma("unroll") for (int k = 0; k < 2; ++k) dst[m][k] = *(const PG8_LAS bf16x8*)(lds + PG8_SA(b, h) + aoff + m * 2048 + k * 1024); } while (0)
#define PG8_LDB(dst, b, h) do { _Pragma("unroll") for (int n = 0; n < 2; ++n) _Pragma("unroll") for (int k = 0; k < 2; ++k) dst[n][k] = *(const PG8_LAS bf16x8*)(lds + PG8_SB(b, h) + boff + n * 2048 + k * 1024); } while (0)
#define PG8_MMA(ai, bj, At, Bt) do { __builtin_amdgcn_s_setprio(1); _Pragma("unroll") for (int m = 0; m < 4; ++m) _Pragma("unroll") for (int n = 0; n < 2; ++n) _Pragma("unroll") for (int k = 0; k < 2; ++k) \
        acc[ai][bj][m][n] = __builtin_amdgcn_mfma_f32_16x16x32_bf16(Bt[n][k], At[m][k], acc[ai][bj][m][n], 0, 0, 0); __builtin_amdgcn_s_setprio(0); } while (0)
#define PG8_WAIT_V(n) asm volatile("s_waitcnt vmcnt(" #n ")" ::: "memory")
#define PG8_WAIT_L(n) asm volatile("s_waitcnt lgkmcnt(" #n ")" ::: "memory")
#define PG8_BAR __builtin_amdgcn_s_barrier()
#define PG8_SCHED __builtin_amdgcn_sched_barrier(0)
    Unit cur, nxt; int ui = 0;
    if (!S.next(0, cur)) return;
    f32x4 acc[2][2][4][2];
#pragma unroll
    for (int a = 0; a < 2; ++a)
#pragma unroll
        for (int b = 0; b < 2; ++b)
#pragma unroll
            for (int m = 0; m < 4; ++m)
#pragma unroll
                for (int n = 0; n < 2; ++n) acc[a][b][m][n] = (f32x4){0.f, 0.f, 0.f, 0.f};
    bf16x8 At[4][2], B0[2][2], B1[2][2];
    const char* cA = (const char*)g.A + (size_t)cur.pm * tstep; const char* cB = (const char*)g.Bt + (size_t)cur.pn * tstep;
    S.a_ready(cur);
    PG8_STAGE(PG8_SB(0, 0), cB, voffB); PG8_STAGE(PG8_SA(0, 0), cA, voffA); PG8_STAGE(PG8_SB(0, 1), cB + hstep, voffB); PG8_STAGE(PG8_SA(0, 1), cA + hstep, voffA);
    if (wr == 1) PG8_BAR;
    PG8_WAIT_V(4); PG8_BAR;
    PG8_STAGE(PG8_SB(1, 0), cB + kstep, voffB); PG8_STAGE(PG8_SA(1, 0), cA + kstep, voffA); PG8_STAGE(PG8_SB(1, 1), cB + hstep + kstep, voffB);
    PG8_WAIT_V(6); PG8_BAR;
    PG8_STAMP();
    for (;;) {
        const bool has_next = S.next(ui + 1, nxt);
        const char* nA = has_next ? (const char*)g.A + (size_t)nxt.pm * tstep : cA; const char* nB = has_next ? (const char*)g.Bt + (size_t)nxt.pn * tstep : cB;
        for (int t = 0; t < nt; t += 2) {
            const bool last = (t == nt - 2);
            const char* a1 = cA + (size_t)(t + 1) * kstep;
            const char* a2 = last ? nA : cA + (size_t)(t + 2) * kstep; const char* b2 = last ? nB : cB + (size_t)(t + 2) * kstep;
            const char* a3 = a2 + kstep; const char* b3 = b2 + kstep;
            if (last && has_next) S.a_ready(nxt);
            PG8_LDB(B0, 0, 0); PG8_SCHED; PG8_LDA(At, 0, 0); PG8_STAGE(PG8_SA(1, 1), a1 + hstep, voffA);
            PG8_WAIT_L(8); PG8_BAR; PG8_WAIT_L(0); PG8_MMA(0, 0, At, B0); PG8_BAR; PG8_SCHED;
            PG8_LDB(B1, 0, 1); PG8_STAGE(PG8_SB(0, 0), b2, voffB);
            PG8_BAR; PG8_WAIT_L(0); PG8_MMA(0, 1, At, B1); PG8_BAR;
            PG8_LDA(At, 0, 1); PG8_STAGE(PG8_SA(0, 0), a2, voffA);
            PG8_BAR; PG8_WAIT_L(0); PG8_MMA(1, 0, At, B0); PG8_BAR; PG8_SCHED;
            PG8_STAGE(PG8_SB(0, 1), b2 + hstep, voffB);
            PG8_WAIT_V(6); PG8_BAR; PG8_MMA(1, 1, At, B1); PG8_BAR;
            PG8_LDB(B0, 1, 0); PG8_SCHED; PG8_LDA(At, 1, 0); PG8_STAGE(PG8_SA(0, 1), a2 + hstep, voffA);
            PG8_WAIT_L(8); PG8_BAR; PG8_WAIT_L(0); PG8_MMA(0, 0, At, B0); PG8_BAR; PG8_SCHED;
            PG8_LDB(B1, 1, 1); PG8_STAGE(PG8_SB(1, 0), b3, voffB);
            PG8_BAR; PG8_WAIT_L(0); PG8_MMA(0, 1, At, B1); PG8_BAR;
            PG8_LDA(At, 1, 1); PG8_STAGE(PG8_SA(1, 0), a3, voffA);
            PG8_BAR; PG8_WAIT_L(0); PG8_MMA(1, 0, At, B0); PG8_BAR; PG8_SCHED;
            PG8_STAGE(PG8_SB(1, 1), b3 + hstep, voffB);
            PG8_WAIT_V(6); PG8_BAR; PG8_MMA(1, 1, At, B1); PG8_BAR;
        }
        PG8_STAMP();
        if constexpr (!Epi::AFTER_DRAIN) { E(acc, cur, wr, wc, fr, fq); S.done(cur); }
        PG8_STAMP();
        if (!has_next) break;
#pragma unroll
        for (int a = 0; a < 2; ++a)
#pragma unroll
            for (int b = 0; b < 2; ++b)
#pragma unroll
                for (int m = 0; m < 4; ++m)
#pragma unroll
                    for (int n = 0; n < 2; ++n) acc[a][b][m][n] = (f32x4){0.f, 0.f, 0.f, 0.f};
        cur = nxt; cA = nA; cB = nB; ++ui;
    }
    PG8_WAIT_V(0);
    if (wr == 0) PG8_BAR;
    PG8_BAR;
    if constexpr (Epi::AFTER_DRAIN) { E.fused(acc, cur, wr, wc, fr, fq, lds, wid, lane); S.done(cur); }
    PG8_STAMP();
    if (STAMP && wid == 0) { stamps[lane] = lane < nts ? (((unsigned long long)(unsigned)ts_hi << 32) | (unsigned)ts_lo) : 0ull;
        if (lane == 62) stamps[62] = rt_entry; if (lane == 63) stamps[63] = (unsigned long long)wall_clock64(); }
#undef PG8_STAMP
#undef PG8_SA
#undef PG8_SB
#undef PG8_STAGE
#undef PG8_LDA
#undef PG8_LDB
#undef PG8_MMA
#undef PG8_WAIT_V
#undef PG8_WAIT_L
#undef PG8_BAR
#undef PG8_SCHED
}
}

#ifndef STOP_AFTER
#define STOP_AFTER 99
#endif
namespace cg = cooperative_groups;
using pg8::bf16_t; using pg8::bf16x8; using pg8::f32x4; using pg8::u32x4; using pg8::Unit;
#define LAS __attribute__((address_space(3)))
#define DI __device__ __forceinline__
typedef unsigned u32x2 __attribute__((ext_vector_type(2)));

constexpr int DM = 1024, NP = 65536, NS = 512, NTOK = NP + NS, SEQ = 4096, NB_P = 16, NB_S = 32, TS = 16;
constexpr int INC = 4112, NMAIN = 4096, DFF = 4096, NMEM = 256;
constexpr float EPS = 1e-6f;
constexpr float SCALE_H = 0.08838834764831845f;
constexpr size_t O_Y = 0, O_PC = (size_t)NTOK * DM, O_PN = O_PC + 16 * 4 * 128 * 128, O_PM = O_PN + 16 * 4 * 128, O_PS = O_PM + 64,
                 O_PCONV = O_PS + 16 * 4 * 128 * 128, O_PMK = O_PCONV + 16 * 3 * 1536, O_PMV = O_PMK + (size_t)16 * 256 * 1024,
                 O_SC = O_PMV + (size_t)16 * 256 * 1024, O_SN = O_SC + 32 * 4 * 128 * 128, O_SM = O_SN + 32 * 4 * 128, O_SS = O_SM + 128,
                 O_SCONV = O_SS + 32 * 4 * 128 * 128, O_END = O_SCONV + 32 * 3 * 1536;
constexpr size_t W_IN = 0, W_OUT = W_IN + (size_t)NMAIN * DM * 2, W_Q = W_OUT + (size_t)DM * DM * 2, W_K = W_Q + (size_t)DM * DM * 2, W_V = W_K + (size_t)DM * DM * 2,
                 W_O = W_V + (size_t)DM * DM * 2, W_1 = W_O + (size_t)DM * DM * 2, W_2 = W_1 + (size_t)DFF * DM * 2,
                 W_PROJ = W_2 + (size_t)DFF * DM * 2, W_HCAT = W_PROJ + (size_t)NTOK * NMAIN * 2, W_GATES = W_HCAT + (size_t)NTOK * DM * 2,
                 W_MN = W_GATES + (size_t)NTOK * 16 * 4, W_KBP = W_MN + (size_t)4096 * DM * 2, W_VTP = W_KBP + (size_t)4096 * DM * 2,
                 W_KBS = W_VTP + (size_t)4096 * DM * 2, W_VTS = W_KBS + (size_t)8192 * DM * 2, W_TAB = W_VTS + (size_t)8192 * DM * 2,
                 W_XBS = W_TAB + 4096  , W_QS = W_XBS + (size_t)NS * DM * 2  , W_HS = W_QS + (size_t)NS * DM * 2  , W_CTL = W_HS + (size_t)NS * DFF * 2  , W_SQ1 = W_CTL + 8192, W_SQ2 = W_SQ1 + (size_t)NTOK * 64, W_RS1 = W_SQ2 + (size_t)NTOK * 64, W_RS2 = W_RS1 + (size_t)NTOK * 4, W_XN = W_RS2 + (size_t)NTOK * 4, W_QKVC = W_XN  , W_END = W_XN + (size_t)NTOK * 1536 * 2;
constexpr int LDS_BYTES = 156 * 1024;

struct Params {
    const float *x_prompt, *x_sample, *st_C, *st_n, *st_m, *st_S, *st_conv, *cache_k, *cache_v, *mem_prompt;
    const float *norm_mix_w, *w_in, *ig_b, *fg_b, *mlstm_norm_w, *conv_w, *A_log, *dt_bias, *gdn_norm_w, *w_out;
    const float *norm_x_w, *norm_mem_w, *wq, *wk, *wv, *wo, *norm_ffn_w, *w1, *w2, *norm_final_w;
    float* out; unsigned char* ws;
};

DI unsigned pk2(float lo, float hi) { unsigned r; asm("v_cvt_pk_bf16_f32 %0, %1, %2" : "=v"(r) : "v"(lo), "v"(hi)); return r; }
DI unsigned pk2a(float lo, float hi) { unsigned r; asm volatile("v_cvt_pk_bf16_f32 %0, %1, %2" : "=v"(r) : "v"(lo), "v"(hi)); return r; }
typedef short s16x4 __attribute__((ext_vector_type(4)));
typedef float f32x2_ __attribute__((ext_vector_type(2)));
typedef __bf16 bf16x2_ __attribute__((ext_vector_type(2)));
DI s16x4 pack4(f32x4 v) { const f32x2_ a = {v.x, v.y}, b = {v.z, v.w}; u32x2 u; u.x = __builtin_bit_cast(unsigned, __builtin_convertvector(a, bf16x2_)); u.y = __builtin_bit_cast(unsigned, __builtin_convertvector(b, bf16x2_)); return __builtin_bit_cast(s16x4, u); }
DI bf16_t f2bf(float f) { return __builtin_bit_cast(unsigned short, (__bf16)f); }
DI float bf2f(bf16_t b) { return __uint_as_float(((unsigned)b) << 16); }
DI float bflo(unsigned u) { return __uint_as_float(u << 16); }
DI float bfhi(unsigned u) { return __uint_as_float(u & 0xffff0000u); }
DI int get_tid() { int t = threadIdx.x; asm volatile("" : "+v"(t)); return t; }
DI float wave_sum(float v) {
#pragma unroll
    for (int o = 1; o < 64; o <<= 1) v += __shfl_xor(v, o);
    return v;
}
DI float sigmoidf_(float x) { return 1.f / (1.f + __expf(-x)); }
#define LDS_WAIT() asm volatile("s_waitcnt lgkmcnt(0)" ::: "memory")
DI void lds_barrier() { asm volatile("s_waitcnt lgkmcnt(0)" ::: "memory"); __builtin_amdgcn_s_barrier(); asm volatile("" ::: "memory"); }

template <int K> DI f32x4 mm16(const LAS bf16_t* A, int lda, const LAS bf16_t* B, int ldb, f32x4 acc, int lane) {
    const LAS bf16_t* pa = A + (lane & 15) * lda + (lane >> 4) * 8;
    const LAS bf16_t* pb = B + (lane & 15) * ldb + (lane >> 4) * 8;
#pragma unroll
    for (int k = 0; k < K; k += 32) {
        const bf16x8 a = *(const LAS bf16x8*)(pa + k), b = *(const LAS bf16x8*)(pb + k);
        acc = __builtin_amdgcn_mfma_f32_16x16x32_bf16(a, b, acc, 0, 0, 0);
    }
    return acc;
}

template <int ACT, bool ROWSCALE> struct EpiBf16 {
    static constexpr bool PERM = true, AFTER_DRAIN = false;
    bf16_t* O; int ldc; const float* rstd;
    DI void operator()(const f32x4 (&acc)[2][2][4][2], const Unit& u, int wr, int wc, int fr, int fq) const {
        const int row0 = u.pm * 256 + wr * 64 + fr, col0 = u.pn * 256 + wc * 32 + 8 * fq;
        float rsv[2][4];
        if (ROWSCALE) {
#pragma unroll
            for (int ai = 0; ai < 2; ++ai)
#pragma unroll
                for (int m = 0; m < 4; ++m) rsv[ai][m] = rsqrtf(rstd[row0 + ai * 128 + m * 16] * (1.f / DM) + EPS); }
#pragma unroll
        for (int ai = 0; ai < 2; ++ai)
#pragma unroll
            for (int m = 0; m < 4; ++m) { const int row = row0 + ai * 128 + m * 16; bf16_t* rowp = O + (size_t)row * ldc + col0; const float rs = ROWSCALE ? rsv[ai][m] : 1.f;
#pragma unroll
                for (int bj = 0; bj < 2; ++bj) { f32x4 v0 = acc[ai][bj][m][0], v1 = acc[ai][bj][m][1];
                    if (ROWSCALE) { v0 = v0 * rs; v1 = v1 * rs; }
                    if (ACT == 1) {
#pragma unroll
                        for (int e = 0; e < 4; ++e) { float a = fmaxf(v0[e], 0.f), b = fmaxf(v1[e], 0.f); v0[e] = a * a; v1[e] = b * b; } }
                    u32x4 o; o.x = pk2a(v0[0], v0[1]); o.y = pk2a(v0[2], v0[3]); o.z = pk2a(v1[0], v1[1]); o.w = pk2a(v1[2], v1[3]);
                    *(u32x4*)(rowp + bj * 128) = o; } }
    }
};
struct EpiF32 {
    static constexpr bool PERM = false, AFTER_DRAIN = false;
    float* C; int ldc;
    DI void operator()(const f32x4 (&acc)[2][2][4][2], const Unit& u, int wr, int wc, int fr, int fq) const {
        const int row0 = u.pm * 256 + wr * 64 + fr, col0 = u.pn * 256 + wc * 32 + 4 * fq;
#pragma unroll
        for (int ai = 0; ai < 2; ++ai)
#pragma unroll
            for (int m = 0; m < 4; ++m) { float* rowp = C + (size_t)(row0 + ai * 128 + m * 16) * ldc + col0;
#pragma unroll
                for (int bj = 0; bj < 2; ++bj)
#pragma unroll
                    for (int n = 0; n < 2; ++n) *(f32x4*)(rowp + bj * 128 + n * 16) = acc[ai][bj][m][n]; }
    }
};
struct EpiRes {
    static constexpr bool PERM = false, AFTER_DRAIN = false;
    float* out; const float* resP; const float* resS;
    DI void operator()(const f32x4 (&acc)[2][2][4][2], const Unit& u, int wr, int wc, int fr, int fq) const {
        const int row0 = u.pm * 256 + wr * 64 + fr, col0 = u.pn * 256 + wc * 32 + 4 * fq;
        const float* rbase = (u.pm < NP / 256) ? resP + (size_t)row0 * DM : resS + (size_t)(row0 - NP) * DM;
#pragma unroll
        for (int ai = 0; ai < 2; ++ai)
#pragma unroll
            for (int m = 0; m < 4; ++m) { const size_t ro = (size_t)(ai * 128 + m * 16) * DM + col0; const float* rp = rbase + ro; float* op = out + (size_t)row0 * DM + ro;
#pragma unroll
                for (int bj = 0; bj < 2; ++bj)
#pragma unroll
                    for (int n = 0; n < 2; ++n) *(f32x4*)(op + bj * 128 + n * 16) = *(const f32x4*)(rp + bj * 128 + n * 16) + acc[ai][bj][m][n]; }
    }
};
struct EpiResSq {
    static constexpr bool PERM = false, AFTER_DRAIN = false;
    float* out; const float* resP; const float* resS; bf16_t* XB; float* sq;
    DI void operator()(const f32x4 (&acc)[2][2][4][2], const Unit& u, int wr, int wc, int fr, int fq) const {
        const int row0 = u.pm * 256 + wr * 64 + fr, col0 = u.pn * 256 + wc * 32 + 4 * fq;
        const float* rbase = (u.pm < NP / 256) ? resP + (size_t)row0 * DM : resS + (size_t)(row0 - NP) * DM;
#pragma unroll
        for (int ai = 0; ai < 2; ++ai)
#pragma unroll
            for (int m = 0; m < 4; ++m) { const size_t ro = (size_t)(ai * 128 + m * 16) * DM + col0; const float* rp = rbase + ro; float* op = out + (size_t)row0 * DM + ro; bf16_t* xp = XB + (size_t)row0 * DM + ro;
                float ss = 0.f;
#pragma unroll
                for (int bj = 0; bj < 2; ++bj)
#pragma unroll
                    for (int n = 0; n < 2; ++n) { const f32x4 v = *(const f32x4*)(rp + bj * 128 + n * 16) + acc[ai][bj][m][n]; *(f32x4*)(op + bj * 128 + n * 16) = v;
                        ss += (v.x * v.x + v.y * v.y) + (v.z * v.z + v.w * v.w);
                        u32x2 o; o.x = pk2(v.x, v.y); o.y = pk2(v.z, v.w); *(u32x2*)(xp + bj * 128 + n * 16) = o; }
                ss += __shfl_xor(ss, 16); ss += __shfl_xor(ss, 32);
                if (fq == 0) sq[(size_t)(row0 + ai * 128 + m * 16) * 16 + u.pn * 4 + wc] = ss; }
    }
};
template <bool RESF32> struct EpiResB {
    static constexpr bool PERM = true, AFTER_DRAIN = false;
    const float* resF; const bf16_t* resB; bf16_t* XB; float* sq;
    DI void finish(f32x4 v0, f32x4 v1, float& ss, bf16_t* dst) const {
        ss += ((v0.x * v0.x + v0.y * v0.y) + (v0.z * v0.z + v0.w * v0.w)) + ((v1.x * v1.x + v1.y * v1.y) + (v1.z * v1.z + v1.w * v1.w));
        u32x4 o; o.x = pk2(v0.x, v0.y); o.y = pk2(v0.z, v0.w); o.z = pk2(v1.x, v1.y); o.w = pk2(v1.z, v1.w);
        *(u32x4*)dst = o; }
    DI void rowsum(float ss, int row, int fq) const {
        ss += __shfl_xor(ss, 16); ss += __shfl_xor(ss, 32);
        if (fq == 0 && sq) __hip_atomic_fetch_add(sq + row, ss, __ATOMIC_RELAXED, __HIP_MEMORY_SCOPE_AGENT); }
    DI void operator()(const f32x4 (&acc)[2][2][4][2], const Unit& u, int wr, int wc, int fr, int fq) const {
        const int row0 = u.pm * 256 + wr * 64 + fr, col0 = u.pn * 256 + wc * 32 + 8 * fq;
        if (!RESF32) {
#pragma unroll
            for (int ai = 0; ai < 2; ++ai) { u32x4 rr[4][2];
#pragma unroll
                for (int m = 0; m < 4; ++m)
#pragma unroll
                    for (int bj = 0; bj < 2; ++bj) rr[m][bj] = *(const u32x4*)(resB + (size_t)(row0 + ai * 128 + m * 16) * DM + col0 + bj * 128);
#pragma unroll
                for (int m = 0; m < 4; ++m) { const size_t ro = (size_t)(row0 + ai * 128 + m * 16) * DM + col0; float ss = 0.f;
#pragma unroll
                    for (int bj = 0; bj < 2; ++bj) { f32x4 v0 = acc[ai][bj][m][0], v1 = acc[ai][bj][m][1]; const u32x4 r = rr[m][bj];
                        v0.x += bflo(r.x); v0.y += bfhi(r.x); v0.z += bflo(r.y); v0.w += bfhi(r.y); v1.x += bflo(r.z); v1.y += bfhi(r.z); v1.z += bflo(r.w); v1.w += bfhi(r.w);
                        finish(v0, v1, ss, XB + ro + bj * 128); }
                    rowsum(ss, row0 + ai * 128 + m * 16, fq); } }
        } else {
#pragma unroll
            for (int ai = 0; ai < 2; ++ai) { f32x4 rf[4][2][2];
#pragma unroll
                for (int m = 0; m < 4; ++m)
#pragma unroll
                    for (int bj = 0; bj < 2; ++bj) { const float* rp = resF + (size_t)(row0 + ai * 128 + m * 16) * DM + col0 + bj * 128; rf[m][bj][0] = *(const f32x4*)rp; rf[m][bj][1] = *(const f32x4*)(rp + 4); }
#pragma unroll
                for (int m = 0; m < 4; ++m) { const size_t ro = (size_t)(row0 + ai * 128 + m * 16) * DM + col0; float ss = 0.f;
#pragma unroll
                    for (int bj = 0; bj < 2; ++bj) finish(acc[ai][bj][m][0] + rf[m][bj][0], acc[ai][bj][m][1] + rf[m][bj][1], ss, XB + ro + bj * 128);
                    rowsum(ss, row0 + ai * 128 + m * 16, fq); } }
        }
    }
};
template <class Epi> DI void run_gemm(LAS unsigned char* lds, const bf16_t* A, const bf16_t* Bt, int M, int N, int K, const Epi& E, int cshift, int G = 0, int c0 = 0) {
    pg8::Gemm g; g.A = A; g.Bt = Bt; g.M = M; g.N = N; g.K = K;
    if (G == 0) { G = (int)gridDim.x; c0 = (int)blockIdx.x; }
    pg8::StaticOrder S; S.init(M, N, G, (c0 + G - cshift) % G);
    pg8::gemm_phase<Epi, pg8::StaticOrder, false>(lds, g, S, E, nullptr);
    __syncthreads();
}

DI void transpose_item(const float* src, int ld, bf16_t* dst, int ldd, LAS float* scr, int k0, int n0, int lane, const float* ksc = nullptr) {
#pragma unroll
    for (int i = 0; i < 32; ++i) { const int kk = 2 * i + (lane >> 5); float x = src[(size_t)(k0 + kk) * ld + n0 + (lane & 31)]; if (ksc) x *= ksc[k0 + kk]; scr[kk * 33 + (lane & 31)] = x; }
    LDS_WAIT();
    const int c = lane & 7;
#pragma unroll
    for (int j = 0; j < 4; ++j) { const int n = (lane >> 3) + 8 * j; const LAS float* s = scr + (8 * c) * 33 + n;
        u32x4 o; o.x = pk2(s[0 * 33], s[1 * 33]); o.y = pk2(s[2 * 33], s[3 * 33]); o.z = pk2(s[4 * 33], s[5 * 33]); o.w = pk2(s[6 * 33], s[7 * 33]);
        *(u32x4*)(dst + (size_t)(n0 + n) * ldd + k0 + 8 * c) = o; }
    LDS_WAIT();
}
DI void load_row(f32x4 (&v)[4], const float* xrow, int lane) {
#pragma unroll
    for (int j = 0; j < 4; ++j) v[j] = *(const f32x4*)(xrow + 4 * lane + 256 * j);
}
template <bool GATES> DI void norm_row(f32x4 (&v)[4], const float* w, bf16_t* orow, float* grow, const LAS float* wg, int lane) {
    float s = 0.f;
#pragma unroll
    for (int j = 0; j < 4; ++j) s += (v[j].x * v[j].x + v[j].y * v[j].y) + (v[j].z * v[j].z + v[j].w * v[j].w);
    const float rstd = rsqrtf(wave_sum(s) * (1.f / DM) + EPS);
#pragma unroll
    for (int j = 0; j < 4; ++j) { const f32x4 wv = *(const f32x4*)(w + 4 * lane + 256 * j); v[j] = v[j] * rstd * wv;
        u32x2 o; o.x = pk2(v[j].x, v[j].y); o.y = pk2(v[j].z, v[j].w); *(u32x2*)(orow + 4 * lane + 256 * j) = o; }
    if (GATES) {
        float g[16];
#pragma unroll
        for (int gi = 0; gi < 16; ++gi) { float a = 0.f;
#pragma unroll
            for (int j = 0; j < 4; ++j) { const f32x4 ww = *(const LAS f32x4*)(wg + gi * 1024 + 4 * lane + 256 * j); a += (v[j].x * ww.x + v[j].y * ww.y) + (v[j].z * ww.z + v[j].w * ww.w); }
            g[gi] = a; }
#pragma unroll
        for (int i = 0; i < 8; ++i) { const bool up = lane & 1; const float send = up ? g[i] : g[i + 8], keep = up ? g[i + 8] : g[i]; g[i] = keep + __shfl_xor(send, 1); }
#pragma unroll
        for (int i = 0; i < 4; ++i) { const bool up = lane & 2; const float send = up ? g[i] : g[i + 4], keep = up ? g[i + 4] : g[i]; g[i] = keep + __shfl_xor(send, 2); }
#pragma unroll
        for (int i = 0; i < 2; ++i) { const bool up = lane & 4; const float send = up ? g[i] : g[i + 2], keep = up ? g[i + 2] : g[i]; g[i] = keep + __shfl_xor(send, 4); }
        { const bool up = lane & 8; const float send = up ? g[0] : g[1], keep = up ? g[1] : g[0]; g[0] = keep + __shfl_xor(send, 8); }
        g[0] += __shfl_xor(g[0], 16); g[0] += __shfl_xor(g[0], 32);
        const int idx = ((lane & 1) << 3) | ((lane & 2) << 1) | ((lane & 4) >> 1) | ((lane & 8) >> 3);
        if (lane < 16) grow[idx] = g[0];
    }
}
DI void norm_row2_gates(f32x4 (&v0)[4], f32x4 (&v1)[4], const float* w, bf16_t* orow0, bf16_t* orow1, float* grow0, float* grow1, const LAS float* wg, int lane) {
    float s0 = 0.f, s1 = 0.f;
#pragma unroll
    for (int j = 0; j < 4; ++j) { s0 += (v0[j].x * v0[j].x + v0[j].y * v0[j].y) + (v0[j].z * v0[j].z + v0[j].w * v0[j].w); s1 += (v1[j].x * v1[j].x + v1[j].y * v1[j].y) + (v1[j].z * v1[j].z + v1[j].w * v1[j].w); }
#pragma unroll
    for (int o = 1; o < 64; o <<= 1) { s0 += __shfl_xor(s0, o); s1 += __shfl_xor(s1, o); }
    const float r0 = rsqrtf(s0 * (1.f / DM) + EPS), r1 = rsqrtf(s1 * (1.f / DM) + EPS);
#pragma unroll
    for (int j = 0; j < 4; ++j) { const f32x4 wv = *(const f32x4*)(w + 4 * lane + 256 * j); v0[j] = v0[j] * r0 * wv; v1[j] = v1[j] * r1 * wv;
        u32x2 o; o.x = pk2(v0[j].x, v0[j].y); o.y = pk2(v0[j].z, v0[j].w); *(u32x2*)(orow0 + 4 * lane + 256 * j) = o;
        u32x2 p; p.x = pk2(v1[j].x, v1[j].y); p.y = pk2(v1[j].z, v1[j].w); *(u32x2*)(orow1 + 4 * lane + 256 * j) = p; }
    float g[32];
#pragma unroll
    for (int gi = 0; gi < 16; ++gi) { float a = 0.f, b = 0.f;
#pragma unroll
        for (int j = 0; j < 4; ++j) { const f32x4 ww = *(const LAS f32x4*)(wg + gi * 1024 + 4 * lane + 256 * j);
            a += (v0[j].x * ww.x + v0[j].y * ww.y) + (v0[j].z * ww.z + v0[j].w * ww.w); b += (v1[j].x * ww.x + v1[j].y * ww.y) + (v1[j].z * ww.z + v1[j].w * ww.w); }
        g[gi] = a; g[16 + gi] = b; }
#pragma unroll
    for (int i = 0; i < 16; ++i) { const bool up = lane & 1; const float send = up ? g[i] : g[i + 16], keep = up ? g[i + 16] : g[i]; g[i] = keep + __shfl_xor(send, 1); }
#pragma unroll
    for (int i = 0; i < 8; ++i) { const bool up = lane & 2; const float send = up ? g[i] : g[i + 8], keep = up ? g[i + 8] : g[i]; g[i] = keep + __shfl_xor(send, 2); }
#pragma unroll
    for (int i = 0; i < 4; ++i) { const bool up = lane & 4; const float send = up ? g[i] : g[i + 4], keep = up ? g[i + 4] : g[i]; g[i] = keep + __shfl_xor(send, 4); }
#pragma unroll
    for (int i = 0; i < 2; ++i) { const bool up = lane & 8; const float send = up ? g[i] : g[i + 2], keep = up ? g[i + 2] : g[i]; g[i] = keep + __shfl_xor(send, 8); }
    { const bool up = lane & 16; const float send = up ? g[0] : g[1], keep = up ? g[1] : g[0]; g[0] = keep + __shfl_xor(send, 16); }
    g[0] += __shfl_xor(g[0], 32);
    const int idx = ((lane & 1) << 4) | ((lane & 2) << 2) | (lane & 4) | ((lane & 8) >> 2) | ((lane & 16) >> 4);
    if (lane < 32) ((idx & 16) ? grow1 : grow0)[idx & 15] = g[0];
}
DI void transpose_matrix(const float* src, int ld, int K, int N, bf16_t* dst, LAS float* scr, int& cursor, int gw, int NGW, int lane, const float* ksc = nullptr) {
    const int nkb = K / 64, nnb = N / 32, items = nkb * nnb;
    int first = (gw - cursor % NGW + NGW) % NGW;
    for (int it = first; it < items; it += NGW) { const int kb = it / nnb, nb = it % nnb; transpose_item(src, ld, dst, K, scr, kb * 64, nb * 32, lane, ksc); }
    cursor += items;
}

DI void phase0(const Params& P, LAS unsigned char* lds) {
    const int tid = get_tid(), lane = tid & 63, wave = tid >> 6, gw = blockIdx.x * 8 + wave, NGW = gridDim.x * 8;
    LAS float* wg = (LAS float*)lds;
    LAS float* scr = (LAS float*)(lds + 65536 + wave * 8448);
    for (int i = tid; i < 16 * 1024; i += 512) { const int g = i >> 10, k = i & 1023; const int col = g < 8 ? 2048 + g : 4104 + (g - 8); wg[i] = P.w_in[(size_t)k * INC + col]; }
    __syncthreads();
    bf16_t* WS = (bf16_t*)P.ws;
    { float* q1 = (float*)(P.ws + W_SQ1); float* q2 = (float*)(P.ws + W_SQ2); for (int i = blockIdx.x * 512 + tid; i < NTOK; i += gridDim.x * 512) { q1[i] = 0.f; q2[i] = 0.f; } }
    { bf16_t* XN = (bf16_t*)(P.ws + W_XN); bf16_t* XBSp = (bf16_t*)(P.ws + W_XBS); float* GT = (float*)(P.ws + W_GATES);
      f32x4 v[4], v2[4], nv[4], nv2[4];
      load_row(v, P.x_prompt + (size_t)gw * DM, lane); load_row(v2, P.x_prompt + (size_t)(gw + NGW) * DM, lane);
      for (int r = gw; r < NTOK; r += 2 * NGW) { const int r2 = r + NGW, rn = r + 2 * NGW, rn2 = r + 3 * NGW;
          if (rn < NTOK) load_row(nv, rn < NP ? P.x_prompt + (size_t)rn * DM : P.x_sample + (size_t)(rn - NP) * DM, lane);
          if (rn2 < NTOK) load_row(nv2, rn2 < NP ? P.x_prompt + (size_t)rn2 * DM : P.x_sample + (size_t)(rn2 - NP) * DM, lane);
          bf16_t* o1 = r < NP ? XN + (size_t)r * DM : XBSp + (size_t)(r - NP) * DM; bf16_t* o2 = r2 < NP ? XN + (size_t)r2 * DM : XBSp + (size_t)(r2 - NP) * DM;
          if (r2 < NTOK) norm_row2_gates(v, v2, P.norm_mix_w, o1, o2, GT + (size_t)r * 16, GT + (size_t)r2 * 16, wg, lane);
          else norm_row<true>(v, P.norm_mix_w, o1, GT + (size_t)r * 16, wg, lane);
#pragma unroll
          for (int j = 0; j < 4; ++j) { v[j] = nv[j]; v2[j] = nv2[j]; } }
      bf16_t* MN = (bf16_t*)(P.ws + W_MN);
      load_row(v, P.mem_prompt + (size_t)gw * DM, lane);
      for (int r = gw; r < 4096; r += NGW) { const int rn = r + NGW;
          if (rn < 4096) load_row(nv, P.mem_prompt + (size_t)rn * DM, lane);
          norm_row<false>(v, P.norm_mem_w, MN + (size_t)r * DM, nullptr, wg, lane);
#pragma unroll
          for (int j = 0; j < 4; ++j) v[j] = nv[j]; } }
    int cur = 0;
    transpose_matrix(P.w_in, INC, DM, 2048, (bf16_t*)(P.ws + W_IN), scr, cur, gw, NGW, lane);
    transpose_matrix(P.w_in + 2056, INC, DM, 2048, (bf16_t*)(P.ws + W_IN) + (size_t)2048 * DM, scr, cur, gw, NGW, lane);
    transpose_matrix(P.wk, DM, DM, DM, (bf16_t*)(P.ws + W_K), scr, cur, gw, NGW, lane);
    transpose_matrix(P.wv, DM, DM, DM, (bf16_t*)(P.ws + W_V), scr, cur, gw, NGW, lane);
    (void)WS;
}

DI int swz72(int d, int t) { return d * 72 + ((((t >> 3) ^ (d >> 3)) & 7) << 3) + (t & 7); }
template <int K, bool SA, bool SB> DI f32x4 mm16s(const LAS bf16_t* A, int rowA0, const LAS bf16_t* B, int rowB0, f32x4 acc, int lane) {
    const int ra = rowA0 + (lane & 15), rb = rowB0 + (lane & 15), q = lane >> 4, ga = SA ? (ra >> 3) & 7 : 0, gb = SB ? (rb >> 3) & 7 : 0;
#pragma unroll
    for (int ks = 0; ks < K / 32; ++ks) {
        const bf16x8 a = *(const LAS bf16x8*)(A + ra * 72 + (((4 * ks + q) ^ ga) << 3)), b = *(const LAS bf16x8*)(B + rb * 72 + (((4 * ks + q) ^ gb) << 3));
        acc = __builtin_amdgcn_mfma_f32_16x16x32_bf16(a, b, acc, 0, 0, 0);
    }
    return acc;
}

DI void ldfr128(bf16x8 (&f)[4], const LAS bf16_t* base, int ld, int lane) {
    const LAS bf16_t* p = base + (lane & 15) * ld + (lane >> 4) * 8;
#pragma unroll
    for (int k = 0; k < 4; ++k) f[k] = *(const LAS bf16x8*)(p + 32 * k);
}
template <bool SW> DI void ldfr64(bf16x8 (&f)[2], const LAS bf16_t* img, int row0, int lane) {
    const int r = row0 + (lane & 15), q = lane >> 4, g = SW ? (r >> 3) & 7 : 0;
#pragma unroll
    for (int ks = 0; ks < 2; ++ks) f[ks] = *(const LAS bf16x8*)(img + r * 72 + (((4 * ks + q) ^ g) << 3));
}
DI f32x4 mma4(const bf16x8 (&a)[4], const bf16x8 (&b)[4], f32x4 acc) {
#pragma unroll
    for (int k = 0; k < 4; ++k) acc = __builtin_amdgcn_mfma_f32_16x16x32_bf16(a[k], b[k], acc, 0, 0, 0);
    return acc;
}
DI f32x4 mma2(const bf16x8 (&a)[2], const bf16x8 (&b)[2], f32x4 acc) {
#pragma unroll
    for (int k = 0; k < 2; ++k) acc = __builtin_amdgcn_mfma_f32_16x16x32_bf16(a[k], b[k], acc, 0, 0, 0);
    return acc;
}

DI void phase_conv(const Params& P, LAS unsigned char* lds, int row_lo, int nrows, unsigned gt, unsigned stride) {
    const int tid = get_tid();
    const bf16_t* PROJ = (const bf16_t*)(P.ws + W_PROJ); bf16_t* QC = (bf16_t*)(P.ws + W_QKVC);
    const float* cw = P.conv_w; const float* stc = P.st_conv;
    LAS float* cwl = (LAS float*)lds;
    for (int i = tid; i < 1536; i += 512) *(LAS f32x4*)(cwl + 4 * i) = *(const f32x4*)(cw + 4 * i);
    __syncthreads();
    const unsigned total = (unsigned)nrows * 192u;
    for (unsigned it0 = gt; it0 < total; it0 += 4u * stride) {
        u32x4 x4[4][4];
#pragma unroll
        for (int u = 0; u < 4; ++u) { const unsigned itu = it0 + u * stride, it = itu < total ? itu : it0;
            const int rrel = it / 192u, row = row_lo + rrel, cb = (it - rrel * 192u) * 8, tl = row < NP ? (row & (SEQ - 1)) : ((row - NP) & (TS - 1));
#pragma unroll
            for (int r = 0; r < 4; ++r) { const int back = 3 - r, rr = back <= tl ? row - back : row; x4[u][r] = *(const u32x4*)(PROJ + (size_t)rr * NMAIN + 2048 + cb); } }
#pragma unroll
        for (int u = 0; u < 4; ++u) { const unsigned it = it0 + u * stride;
            if (it < total) {
                const int rrel = it / 192u, row = row_lo + rrel, cg = it - rrel * 192u, cb = cg * 8, tl = row < NP ? (row & (SEQ - 1)) : ((row - NP) & (TS - 1));
                float y[8];
#pragma unroll
                for (int j = 0; j < 8; ++j) y[j] = 0.f;
#pragma unroll
                for (int r = 0; r < 4; ++r) { const LAS float* wp = cwl + r * 1536 + cb; const f32x4 w0 = *(const LAS f32x4*)wp, w1 = *(const LAS f32x4*)(wp + 4);
                    const float mk = (3 - r) <= tl ? 1.f : 0.f;
                    y[0] += mk * w0.x * bflo(x4[u][r][0]); y[1] += mk * w0.y * bfhi(x4[u][r][0]); y[2] += mk * w0.z * bflo(x4[u][r][1]); y[3] += mk * w0.w * bfhi(x4[u][r][1]);
                    y[4] += mk * w1.x * bflo(x4[u][r][2]); y[5] += mk * w1.y * bfhi(x4[u][r][2]); y[6] += mk * w1.z * bflo(x4[u][r][3]); y[7] += mk * w1.w * bfhi(x4[u][r][3]); }
                if (row >= NP && tl < 3) {
                    const int b = (row - NP) >> 4;
                    for (int r = 0; r < 3 - tl; ++r) { const int hist = tl + r;
                        const float* cp = stc + ((size_t)b * 3 + hist) * 1536 + cb; const float* wp = cw + r * 1536 + cb;
#pragma unroll
                        for (int j = 0; j < 8; ++j) y[j] += wp[j] * cp[j]; } }
#pragma unroll
                for (int j = 0; j < 8; ++j) y[j] = y[j] * sigmoidf_(y[j]);
                float ss = 0.f;
#pragma unroll
                for (int j = 0; j < 8; ++j) ss += y[j] * y[j];
                ss += __shfl_xor(ss, 1); ss += __shfl_xor(ss, 2); ss += __shfl_xor(ss, 4); ss += __shfl_xor(ss, 8);
                const float rn = cg < 128 ? rsqrtf(ss + EPS) : 1.f;
                u32x4 o; o.x = pk2(y[0] * rn, y[1] * rn); o.y = pk2(y[2] * rn, y[3] * rn); o.z = pk2(y[4] * rn, y[5] * rn); o.w = pk2(y[6] * rn, y[7] * rn);
                *(u32x4*)(QC + (size_t)row * 1536 + cb) = o; } }
    }
    __syncthreads();
}

DI void mlstm_seq(const Params& P, LAS unsigned char* lds, int b, int h, bool sample) {
    const int tid = get_tid(), lane = tid & 63, w = tid >> 6;
    LAS bf16_t* Qs = (LAS bf16_t*)(lds + 0);
    LAS bf16_t* Ks = (LAS bf16_t*)(lds + 17408);
    LAS bf16_t* Vt = (LAS bf16_t*)(lds + 34816);
    LAS bf16_t* Kwt = (LAS bf16_t*)(lds + 53248);
    LAS bf16_t* C0t = (LAS bf16_t*)(lds + 71680);
    LAS bf16_t* Sm = (LAS bf16_t*)(lds + 106496);
    LAS float* Hf = (LAS float*)(lds + 115712);
    LAS float* sm = (LAS float*)(lds + 149504);
    LAS float *sm_a = sm, *sm_bm = sm + 64, *sm_wi = sm + 128, *sm_ws = sm + 192, *sm_en = sm + 256, *sm_qn = sm + 320, *sm_rs = sm + 384  ,
              *sm_n0 = sm + 640  , *sm_np = sm + 768  , *sm_misc = sm + 1280, *sm_nw = sm + 1288  ;
    const bf16_t* PROJ = (const bf16_t*)(P.ws + W_PROJ); const float* GT = (const float*)(P.ws + W_GATES); bf16_t* HC = (bf16_t*)(P.ws + W_HCAT);
    const int row0 = sample ? NP + b * TS : b * SEQ, nchunks = sample ? 1 : 64, valid = sample ? TS : 64, bh = b * 4 + h;
    const float igb = P.ig_b[h], fgb = P.fg_b[h];
    const int lt = tid >> 4, lch = tid & 15;
    const int nt = tid >> 3, npart = tid & 7;
    f32x4 accs[8]; float m0 = 0.f;
    if (tid < 128) sm_nw[tid] = P.mlstm_norm_w[tid];
    if (sample) { const float* C0 = P.st_C + (size_t)bh * 16384;
#pragma unroll
        for (int j = 0; j < 8; ++j)
#pragma unroll
            for (int r = 0; r < 4; ++r) accs[j][r] = C0[(j * 16 + (lane >> 4) * 4 + r) * 128 + w * 16 + (lane & 15)];
        if (tid < 128) sm_n0[tid] = P.st_n[bh * 128 + tid];
        m0 = P.st_m[bh];
    } else {
#pragma unroll
        for (int j = 0; j < 8; ++j) accs[j] = (f32x4){0.f, 0.f, 0.f, 0.f};
        if (tid < 128) sm_n0[tid] = 0.f;
    }
#pragma unroll
    for (int j = 0; j < 8; ++j) *(LAS s16x4*)(C0t + (w * 16 + (lane & 15)) * 136 + j * 16 + (lane >> 4) * 4) = pack4(accs[j]);
    u32x4 nq[2], nk[2], nv[2], noa0, noa1; float ng0 = 0.f, ng1 = 0.f;
    const u32x4 Z4 = (u32x4){0u, 0u, 0u, 0u};
#define ML_ISSUE_QKV(cc) do { const int r0n_ = row0 + (cc) * 64; _Pragma("unroll") for (int e = 0; e < 2; ++e) { const int t = lt + 32 * e; nq[e] = Z4; nk[e] = Z4; nv[e] = Z4; \
        if (t < valid) { const bf16_t* pr = PROJ + (size_t)(r0n_ + t) * NMAIN + h * 128 + lch * 8; nq[e] = *(const u32x4*)pr; nk[e] = *(const u32x4*)(pr + 512); nv[e] = *(const u32x4*)(pr + 1024); } } \
        if (w == 0 && lane < valid) { const float* gr = GT + (size_t)(r0n_ + lane) * 16; ng0 = gr[h]; ng1 = gr[4 + h]; } } while (0)
#define ML_ISSUE_OA(cc) do { noa0 = Z4; noa1 = Z4; if (nt < valid) { const bf16_t* oa = PROJ + (size_t)(row0 + (cc) * 64 + nt) * NMAIN + 1536 + h * 128 + npart * 16; noa0 = *(const u32x4*)oa; noa1 = *(const u32x4*)(oa + 8); } } while (0)
    ML_ISSUE_QKV(0); ML_ISSUE_OA(0);
    lds_barrier();
    for (int c = 0; c < nchunks; ++c) {
        const int r0 = row0 + c * 64;
        if (w == 0) {
            const int t = lane; float ig = -INFINITY, lf = 0.f;
            if (t < valid) { ig = ng0 + igb; const float f = ng1 + fgb; lf = fminf(f, 0.f) - __logf(1.f + __expf(-fabsf(f))); }
            float bc = lf;
#pragma unroll
            for (int o = 1; o < 64; o <<= 1) { const float u = __shfl_up(bc, o); if (lane >= o) bc += u; }
            const float a = ig - bc; float pm = a;
#pragma unroll
            for (int o = 1; o < 64; o <<= 1) { const float u = __shfl_up(pm, o); if (lane >= o) pm = fmaxf(pm, u); }
            const float mt = bc + fmaxf(m0, pm);
            const float blast = __shfl(bc, 63), mlast = __shfl(mt, 63);
            sm_a[t] = a; sm_bm[t] = bc - mt; sm_wi[t] = __expf(bc + m0 - mt); sm_ws[t] = __expf(blast + a - mlast) * SCALE_H; sm_en[t] = __expf(-mt);
            if (lane == 0) { sm_misc[0] = __expf(blast + m0 - mlast); sm_misc[1] = mlast; }
        }
        lds_barrier();
#pragma unroll
        for (int e = 0; e < 2; ++e) { const int t = lt + 32 * e, ch = lch; const u32x4 q4 = nq[e], k4 = nk[e], v4 = nv[e];
            *(LAS u32x4*)(Qs + t * 136 + ch * 8) = q4; *(LAS u32x4*)(Ks + t * 136 + ch * 8) = k4;
            const float wsv = sm_ws[t];
#pragma unroll
            for (int j = 0; j < 4; ++j) { const unsigned ku = k4[j], vu = v4[j];
                Kwt[swz72(ch * 8 + 2 * j, t)] = f2bf(bflo(ku) * wsv); Kwt[swz72(ch * 8 + 2 * j + 1, t)] = f2bf(bfhi(ku) * wsv);
                Vt[swz72(ch * 8 + 2 * j, t)] = (bf16_t)(vu & 0xffffu); Vt[swz72(ch * 8 + 2 * j + 1, t)] = (bf16_t)(vu >> 16); } }
        if (c + 1 < nchunks) ML_ISSUE_QKV(c + 1);
        lds_barrier();
        { const int t = tid >> 3, part = tid & 7; float s = 0.f;
#pragma unroll
          for (int j = 0; j < 16; ++j) s += bf2f(Qs[t * 136 + part * 16 + j]) * sm_n0[part * 16 + j];
          s += __shfl_xor(s, 1); s += __shfl_xor(s, 2); s += __shfl_xor(s, 4);
          if (part == 0) sm_qn[t] = s; }
        { const int dk = tid & 127, pq = tid >> 7; float s = 0.f;
#pragma unroll
          for (int j = 0; j < 16; ++j) { const int ss = pq * 16 + j; s += sm_ws[ss] * bf2f(Ks[ss * 136 + dk]); }
          sm_np[pq * 128 + dk] = s; }
        const int ti = w >> 1;
        { bf16x8 aq[4]; ldfr128(aq, Qs + ti * 16 * 136, 136, lane);
        float bmr[4];
#pragma unroll
        for (int r = 0; r < 4; ++r) bmr[r] = sm_bm[ti * 16 + (lane >> 4) * 4 + r];
#pragma unroll
        for (int e = 0; e < 2; ++e) { const int si = (w * 2 + e) & 3; f32x4 acc = (f32x4){0.f, 0.f, 0.f, 0.f};
            if (si <= ti) { bf16x8 bk[4]; ldfr128(bk, Ks + si * 16 * 136, 136, lane); acc = mma4(aq, bk, acc); }
            const int s = si * 16 + (lane & 15); const float as = sm_a[s]; float rs[4];
#pragma unroll
            for (int r = 0; r < 4; ++r) { const int t = ti * 16 + (lane >> 4) * 4 + r; const float val = (s <= t) ? acc[r] * SCALE_H * __expf(bmr[r] + as) : 0.f; Sm[t * 72 + s] = f2bf(val); rs[r] = val; }
#pragma unroll
            for (int r = 0; r < 4; ++r) { rs[r] += __shfl_xor(rs[r], 1); rs[r] += __shfl_xor(rs[r], 2); rs[r] += __shfl_xor(rs[r], 4); rs[r] += __shfl_xor(rs[r], 8); }
            if ((lane & 15) == 0) {
#pragma unroll
                for (int r = 0; r < 4; ++r) sm_rs[si * 64 + ti * 16 + (lane >> 4) * 4 + r] = rs[r]; } } }
        lds_barrier();
        { bf16x8 aq[4]; ldfr128(aq, Qs + ti * 16 * 136, 136, lane); bf16x8 asc[2]; ldfr64<false>(asc, Sm, ti * 16, lane);
          float wir[4], invd[4];
#pragma unroll
          for (int r = 0; r < 4; ++r) { const int t = ti * 16 + (lane >> 4) * 4 + r; wir[r] = sm_wi[t];
              const float den = wir[r] * sm_qn[t] + ((sm_rs[t] + sm_rs[64 + t]) + (sm_rs[128 + t] + sm_rs[192 + t]));
              invd[r] = 1.f / fmaxf(fabsf(den), sm_en[t]); }
#pragma unroll 2
          for (int e = 0; e < 4; ++e) { const int di = (w & 1) * 4 + e;
              bf16x8 bc[4]; ldfr128(bc, C0t + di * 16 * 136, 136, lane);
              bf16x8 bv[2]; ldfr64<true>(bv, Vt, di * 16, lane);
              f32x4 acc = mma4(aq, bc, (f32x4){0.f, 0.f, 0.f, 0.f});
#pragma unroll
              for (int r = 0; r < 4; ++r) acc[r] *= wir[r];
              acc = mma2(asc, bv, acc);
#pragma unroll
              for (int r = 0; r < 4; ++r) Hf[(ti * 16 + (lane >> 4) * 4 + r) * 132 + di * 16 + (lane & 15)] = acc[r] * invd[r]; } }
        lds_barrier();
        { const int t = nt, part = npart; float hv[16]; float ss = 0.f;
#pragma unroll
          for (int j = 0; j < 4; ++j) { const f32x4 x = *(const LAS f32x4*)(Hf + t * 132 + part * 16 + 4 * j); hv[4 * j] = x.x; hv[4 * j + 1] = x.y; hv[4 * j + 2] = x.z; hv[4 * j + 3] = x.w; ss += (x.x * x.x + x.y * x.y) + (x.z * x.z + x.w * x.w); }
          ss += __shfl_xor(ss, 1); ss += __shfl_xor(ss, 2); ss += __shfl_xor(ss, 4);
          const float rs = rsqrtf(ss * (1.f / 128.f) + EPS);
          if (t < valid) { const u32x4 o0 = noa0, o1 = noa1; const LAS float* nw = sm_nw + part * 16; u32x4 r0v, r1v;
#pragma unroll
              for (int j = 0; j < 4; ++j) { const float a0 = hv[2 * j] * rs * nw[2 * j] * sigmoidf_(bflo(o0[j])), a1 = hv[2 * j + 1] * rs * nw[2 * j + 1] * sigmoidf_(bfhi(o0[j])); r0v[j] = pk2(a0, a1);
                  const float b0 = hv[8 + 2 * j] * rs * nw[8 + 2 * j] * sigmoidf_(bflo(o1[j])), b1 = hv[9 + 2 * j] * rs * nw[9 + 2 * j] * sigmoidf_(bfhi(o1[j])); r1v[j] = pk2(b0, b1); }
              bf16_t* op = HC + (size_t)(r0 + t) * DM + h * 128 + part * 16; *(u32x4*)op = r0v; *(u32x4*)(op + 8) = r1v; }
          if (c + 1 < nchunks) ML_ISSUE_OA(c + 1); }
        { const float d0 = sm_misc[0];
          bf16x8 bvw[2]; ldfr64<true>(bvw, Vt, w * 16, lane);
#pragma unroll
          for (int j = 0; j < 8; ++j) { accs[j] = accs[j] * d0; bf16x8 ak[2]; ldfr64<true>(ak, Kwt, j * 16, lane); accs[j] = mma2(ak, bvw, accs[j]);
              *(LAS s16x4*)(C0t + (w * 16 + (lane & 15)) * 136 + j * 16 + (lane >> 4) * 4) = pack4(accs[j]); }
          if (tid < 128) sm_n0[tid] = d0 * sm_n0[tid] + ((sm_np[tid] + sm_np[128 + tid]) + (sm_np[256 + tid] + sm_np[384 + tid]));
          m0 = sm_misc[1]; }
        lds_barrier();
    }
#undef ML_ISSUE_QKV
#undef ML_ISSUE_OA
    { float* Co = P.out + (sample ? O_SC : O_PC) + (size_t)bh * 16384;
#pragma unroll
      for (int j = 0; j < 8; ++j)
#pragma unroll
          for (int r = 0; r < 4; ++r) Co[(j * 16 + (lane >> 4) * 4 + r) * 128 + w * 16 + (lane & 15)] = accs[j][r];
      if (tid < 128) P.out[(sample ? O_SN : O_PN) + bh * 128 + tid] = sm_n0[tid];
      if (tid == 0) P.out[(sample ? O_SM : O_PM) + bh] = m0; }
    lds_barrier();
}

DI void gdn_s2(const LAS bf16_t* __restrict__ Qs, const LAS bf16_t* __restrict__ Ks, LAS bf16_t* __restrict__ Am, LAS bf16_t* __restrict__ QKd, LAS float* __restrict__ Adg,
               const LAS float* __restrict__ sm_G, const LAS float* __restrict__ sm_beta, int w, int lane) {
    const int kind = w >> 2, ti = w & 3; bf16x8 afr[4]; ldfr128(afr, (kind ? Qs : Ks) + ti * 16 * 136, 136, lane);
    float Gt[4], bt[4];
#pragma unroll
    for (int r = 0; r < 4; ++r) { const int t = ti * 16 + (lane >> 4) * 4 + r; Gt[r] = sm_G[t]; bt[r] = sm_beta[t]; }
#pragma unroll 2
    for (int si = 0; si < 4; ++si) { f32x4 acc = (f32x4){0.f, 0.f, 0.f, 0.f};
        if (si <= ti) { bf16x8 bk[4]; ldfr128(bk, Ks + si * 16 * 136, 136, lane); acc = mma4(afr, bk, acc); }
        const int s = si * 16 + (lane & 15); const float Gs = sm_G[s];
#pragma unroll
        for (int r = 0; r < 4; ++r) { const int t = ti * 16 + (lane >> 4) * 4 + r; const float dec = (s <= t) ? __expf(Gt[r] - Gs) : 0.f;
            if (kind == 0) { const float val = (s < t) ? bt[r] * dec * acc[r] : 0.f;
                if (ti == si) { Adg[ti * 320 + (t & 15) * 20 + (s & 15)] = val; Am[t * 72 + s] = 0; } else Am[t * 72 + s] = f2bf(val); }
            else QKd[t * 72 + s] = f2bf(SCALE_H * dec * acc[r]); } }
}

DI void gdn_s6(const LAS bf16_t* __restrict__ Qs, const LAS bf16_t* __restrict__ QKd, LAS float* __restrict__ Of, const LAS float* __restrict__ sm_gam,
               const bf16x8 (&bs)[4], const s16x4 (&Wb)[4], int w, int lane) {
#pragma unroll
    for (int ti = 0; ti < 4; ++ti) {
        bf16x8 aq[4]; ldfr128(aq, Qs + ti * 16 * 136, 136, lane); f32x4 acc = mma4(aq, bs, (f32x4){0.f, 0.f, 0.f, 0.f});
#pragma unroll
        for (int r = 0; r < 4; ++r) acc[r] *= SCALE_H * sm_gam[ti * 16 + (lane >> 4) * 4 + r];
#pragma unroll
        for (int j = 0; j <= ti; ++j) { const s16x4 af = *(const LAS s16x4*)(QKd + (ti * 16 + (lane & 15)) * 72 + j * 16 + (lane >> 4) * 4);
            acc = __builtin_amdgcn_mfma_f32_16x16x16bf16_1k(af, Wb[j], acc, 0, 0, 0); }
#pragma unroll
        for (int r = 0; r < 4; ++r) Of[(ti * 16 + (lane >> 4) * 4 + r) * 132 + w * 16 + (lane & 15)] = acc[r]; }
}

DI void gdn_seq(const Params& P, LAS unsigned char* lds, int b, int h, bool sample) {
    const int tid = get_tid(), lane = tid & 63, w = tid >> 6;
    LAS bf16_t* Qs = (LAS bf16_t*)(lds + 0);
    LAS bf16_t* Ks = (LAS bf16_t*)(lds + 17408);
    LAS bf16_t* Kdt = (LAS bf16_t*)(lds + 35840);
    LAS bf16_t* S0t = (LAS bf16_t*)(lds + 54272);
    LAS bf16_t* QKd = (LAS bf16_t*)(lds + 89088);
    LAS bf16_t* Am = (LAS bf16_t*)(lds + 98304);
    LAS bf16_t* Db = (LAS bf16_t*)(lds + 107520);
    LAS float* Adg = (LAS float*)(lds + 111872);
    LAS float* Rf = (LAS float*)(lds + 116992);
    LAS float* sm = (LAS float*)(lds + 150784);
    LAS float *sm_G = sm, *sm_gam = sm + 64, *sm_beta = sm + 128, *sm_bg = sm + 192, *sm_kd = sm + 256, *sm_misc = sm + 320, *sm_nw = sm + 328  ;
    const bf16_t* PROJ = (const bf16_t*)(P.ws + W_PROJ); const bf16_t* QC = (const bf16_t*)(P.ws + W_QKVC); const float* GT = (const float*)(P.ws + W_GATES); bf16_t* HC = (bf16_t*)(P.ws + W_HCAT);
    const int row0 = sample ? NP + b * TS : b * SEQ, nchunks = sample ? 1 : 64, valid = sample ? TS : 64, bh = b * 4 + h;
    const float Aexp = expf(P.A_log[h]), dtb = P.dt_bias[h];
    const int lt = tid >> 4, lch = tid & 15, nt = tid >> 3, npart = tid & 7;
    f32x4 accs[8];
    if (tid < 128) sm_nw[tid] = P.gdn_norm_w[tid];
    if (sample) { const float* S0 = P.st_S + (size_t)bh * 16384;
#pragma unroll
        for (int j = 0; j < 8; ++j)
#pragma unroll
            for (int r = 0; r < 4; ++r) accs[j][r] = S0[(j * 16 + (lane >> 4) * 4 + r) * 128 + w * 16 + (lane & 15)];
    } else {
#pragma unroll
        for (int j = 0; j < 8; ++j) accs[j] = (f32x4){0.f, 0.f, 0.f, 0.f};
    }
#pragma unroll
    for (int j = 0; j < 8; ++j) *(LAS s16x4*)(S0t + (w * 16 + (lane & 15)) * 136 + j * 16 + (lane >> 4) * 4) = pack4(accs[j]);
    u32x4 nq[2], nk[2], nv[2], nz0, nz1; float ng0 = 0.f, ng1 = 0.f;
    const u32x4 Z4 = (u32x4){0u, 0u, 0u, 0u};
#define GD_ISSUE_QKV(cc) do { const int r0n_ = row0 + (cc) * 64; _Pragma("unroll") for (int e = 0; e < 2; ++e) { const int t = lt + 32 * e; nq[e] = Z4; nk[e] = Z4; nv[e] = Z4; \
        if (t < valid) { const bf16_t* pr = QC + (size_t)(r0n_ + t) * 1536 + h * 128 + lch * 8; nq[e] = *(const u32x4*)pr; nk[e] = *(const u32x4*)(pr + 512); nv[e] = *(const u32x4*)(pr + 1024); } } \
        if (w == 0 && lane < valid) { const float* gr = GT + (size_t)(r0n_ + lane) * 16; ng0 = gr[8 + h]; ng1 = gr[12 + h]; } } while (0)
#define GD_ISSUE_Z(cc) do { nz0 = Z4; nz1 = Z4; if (nt < valid) { const bf16_t* zp = PROJ + (size_t)(row0 + (cc) * 64 + nt) * NMAIN + 3584 + h * 128 + npart * 16; nz0 = *(const u32x4*)zp; nz1 = *(const u32x4*)(zp + 8); } } while (0)
    GD_ISSUE_QKV(0); GD_ISSUE_Z(0);
    lds_barrier();
    for (int c = 0; c < nchunks; ++c) {
        const int r0 = row0 + c * 64;
        if (w == 0) { const int t = lane; float g = 0.f, beta = 0.f;
            if (t < valid) { const float ab = ng0 + dtb; const float sp = fmaxf(ab, 0.f) + __logf(1.f + __expf(-fabsf(ab))); g = -Aexp * sp; beta = 1.f / (1.f + __expf(-ng1)); }
            float G = g;
#pragma unroll
            for (int o = 1; o < 64; o <<= 1) { const float u = __shfl_up(G, o); if (lane >= o) G += u; }
            const float Gl = __shfl(G, 63); const float eg = __expf(G);
            sm_G[t] = G; sm_gam[t] = eg; sm_beta[t] = beta; sm_bg[t] = beta * eg; sm_kd[t] = __expf(Gl - G);
            if (lane == 0) sm_misc[0] = __expf(Gl); }
        lds_barrier();
#pragma unroll
        for (int e = 0; e < 2; ++e) { const int t = lt + 32 * e, ch = lch; const u32x4 q4 = nq[e], k4 = nk[e], v4 = nv[e];
            *(LAS u32x4*)(Qs + t * 136 + ch * 8) = q4; *(LAS u32x4*)(Ks + t * 136 + ch * 8) = k4;
            const float kd = sm_kd[t], bt = sm_beta[t];
#pragma unroll
            for (int j = 0; j < 4; ++j) { const unsigned ku = k4[j];
                Kdt[swz72(ch * 8 + 2 * j, t)] = f2bf(bflo(ku) * kd); Kdt[swz72(ch * 8 + 2 * j + 1, t)] = f2bf(bfhi(ku) * kd); }
            f32x4 v0, v1; v0.x = bt * bflo(v4[0]); v0.y = bt * bfhi(v4[0]); v0.z = bt * bflo(v4[1]); v0.w = bt * bfhi(v4[1]); v1.x = bt * bflo(v4[2]); v1.y = bt * bfhi(v4[2]); v1.z = bt * bflo(v4[3]); v1.w = bt * bfhi(v4[3]);
            *(LAS f32x4*)(Rf + t * 132 + ch * 8) = v0; *(LAS f32x4*)(Rf + t * 132 + ch * 8 + 4) = v1; }
        if (c + 1 < nchunks) GD_ISSUE_QKV(c + 1);
        lds_barrier();
        gdn_s2(Qs, Ks, Am, QKd, Adg, sm_G, sm_beta, w, lane);
        lds_barrier();
        if (w == 0) { const int blk = lane >> 4, cc = lane & 15; const LAS float* Ab = Adg + blk * 320; float X[16];
#pragma unroll
            for (int r = 0; r < 16; ++r) { float s = (cc == r) ? 1.f : 0.f;
#pragma unroll
                for (int q4 = 0; q4 < (r + 3) / 4; ++q4) { const f32x4 av = *(const LAS f32x4*)(Ab + r * 20 + 4 * q4);
                    if (4 * q4 + 0 < r) s -= av.x * X[4 * q4 + 0];
                    if (4 * q4 + 1 < r) s -= av.y * X[4 * q4 + 1];
                    if (4 * q4 + 2 < r) s -= av.z * X[4 * q4 + 2];
                    if (4 * q4 + 3 < r) s -= av.w * X[4 * q4 + 3]; }
                X[r] = s; }
#pragma unroll
            for (int r = 0; r < 16; ++r) Db[blk * 384 + r * 24 + cc] = f2bf(X[r]); }
        f32x4 rhs[4]; bf16x8 bs[4]; ldfr128(bs, S0t + w * 16 * 136, 136, lane);
#pragma unroll
        for (int si = 0; si < 4; ++si) { bf16x8 ak[4]; ldfr128(ak, Ks + si * 16 * 136, 136, lane); const f32x4 acc = mma4(ak, bs, (f32x4){0.f, 0.f, 0.f, 0.f});
#pragma unroll
            for (int r = 0; r < 4; ++r) { const int sr = si * 16 + (lane >> 4) * 4 + r; rhs[si][r] = Rf[sr * 132 + w * 16 + (lane & 15)] - sm_bg[sr] * acc[r]; } }
        lds_barrier();
        s16x4 Wb[4];
#pragma unroll
        for (int i = 0; i < 4; ++i) { f32x4 pacc = (f32x4){0.f, 0.f, 0.f, 0.f};
#pragma unroll
            for (int j = 0; j < i; ++j) { const s16x4 af = *(const LAS s16x4*)(Am + (i * 16 + (lane & 15)) * 72 + j * 16 + (lane >> 4) * 4);
                pacc = __builtin_amdgcn_mfma_f32_16x16x16bf16_1k(af, Wb[j], pacc, 0, 0, 0); }
            const f32x4 rr = rhs[i] - pacc;
            const s16x4 df = *(const LAS s16x4*)(Db + i * 384 + (lane & 15) * 24 + (lane >> 4) * 4);
            const f32x4 wi = __builtin_amdgcn_mfma_f32_16x16x16bf16_1k(df, pack4(rr), (f32x4){0.f, 0.f, 0.f, 0.f}, 0, 0, 0);
            Wb[i] = pack4(wi); }
        gdn_s6(Qs, QKd, Rf, sm_gam, bs, Wb, w, lane);
        { const float dG = sm_misc[0];
#pragma unroll
          for (int j = 0; j < 8; ++j) { accs[j] = accs[j] * dG; const int dk = j * 16 + (lane & 15), gsw = (dk >> 3) & 7;
#pragma unroll
              for (int i = 0; i < 4; ++i) { const s16x4 kf = *(const LAS s16x4*)(Kdt + dk * 72 + ((((2 * i + (lane >> 5)) ^ gsw) & 7) << 3) + ((lane >> 4) & 1) * 4);
                  accs[j] = __builtin_amdgcn_mfma_f32_16x16x16bf16_1k(kf, Wb[i], accs[j], 0, 0, 0); } } }
        lds_barrier();
        {
#pragma unroll
          for (int j = 0; j < 8; ++j) *(LAS s16x4*)(S0t + (w * 16 + (lane & 15)) * 136 + j * 16 + (lane >> 4) * 4) = pack4(accs[j]); }
        { const int t = nt, part = npart; float hv[16]; float ss = 0.f;
#pragma unroll
          for (int j = 0; j < 4; ++j) { const f32x4 x = *(const LAS f32x4*)(Rf + t * 132 + part * 16 + 4 * j); hv[4 * j] = x.x; hv[4 * j + 1] = x.y; hv[4 * j + 2] = x.z; hv[4 * j + 3] = x.w; ss += (x.x * x.x + x.y * x.y) + (x.z * x.z + x.w * x.w); }
          ss += __shfl_xor(ss, 1); ss += __shfl_xor(ss, 2); ss += __shfl_xor(ss, 4);
          const float rs = rsqrtf(ss * (1.f / 128.f) + EPS);
          if (t < valid) { const u32x4 o0 = nz0, o1 = nz1; const LAS float* nw = sm_nw + part * 16; u32x4 r0v, r1v;
#pragma unroll
              for (int j = 0; j < 4; ++j) { const float z0 = bflo(o0[j]), z1 = bfhi(o0[j]), z2 = bflo(o1[j]), z3 = bfhi(o1[j]);
                  const float a0 = hv[2 * j] * rs * nw[2 * j] * z0 * sigmoidf_(z0), a1 = hv[2 * j + 1] * rs * nw[2 * j + 1] * z1 * sigmoidf_(z1); r0v[j] = pk2(a0, a1);
                  const float b0 = hv[8 + 2 * j] * rs * nw[8 + 2 * j] * z2 * sigmoidf_(z2), b1 = hv[9 + 2 * j] * rs * nw[9 + 2 * j] * z3 * sigmoidf_(z3); r1v[j] = pk2(b0, b1); }
              bf16_t* op = HC + (size_t)(r0 + t) * DM + 512 + h * 128 + part * 16; *(u32x4*)op = r0v; *(u32x4*)(op + 8) = r1v; }
          if (c + 1 < nchunks) GD_ISSUE_Z(c + 1); }
        lds_barrier();
    }
#undef GD_ISSUE_QKV
#undef GD_ISSUE_Z
    { float* So = P.out + (sample ? O_SS : O_PS) + (size_t)bh * 16384;
#pragma unroll
      for (int j = 0; j < 8; ++j)
#pragma unroll
          for (int r = 0; r < 4; ++r) So[(j * 16 + (lane >> 4) * 4 + r) * 128 + w * 16 + (lane & 15)] = accs[j][r];
      const int rl = sample ? row0 + TS - 3 : row0 + SEQ - 3; float* co = P.out + (sample ? O_SCONV : O_PCONV) + (size_t)b * 3 * 1536;
      for (int i = tid; i < 3 * 384; i += 512) { const int j = i / 384, q = i % 384, which = q >> 7, d = q & 127, cb = which * 512 + h * 128 + d;
          co[j * 1536 + cb] = bf2f(PROJ[(size_t)(rl + j) * NMAIN + 2048 + cb]); } }
    lds_barrier();
}

DI void phase2(const Params& P, LAS unsigned char* lds, int skipkind) {
    const int wg = blockIdx.x, G = gridDim.x;
    { const int nit = wg < 128 ? 1 : 2;
      for (int k = 0; k < nit; ++k) { const bool sample = wg >= 128; const int s_ = wg - 128 + 128 * k;
          const int kind = sample ? (s_ >= 128) : (wg >= 64); const int loc = sample ? (s_ & 127) : (wg & 63);
          if (kind == skipkind) continue;
          if (kind == 0) mlstm_seq(P, lds, loc >> 2, loc & 3, sample); else gdn_seq(P, lds, loc >> 2, loc & 3, sample); } }
    if (wg >= 128 || G <= 128) { const int nw = G > 128 ? G - 128 : G, me = G > 128 ? wg - 128 : wg, tid = get_tid(), lane = tid & 63, wave = tid >> 6;
        const float* mk = P.out + O_PMK; const float* mv = P.out + O_PMV; bf16_t* KB = (bf16_t*)(P.ws + W_KBP); bf16_t* VT = (bf16_t*)(P.ws + W_VTP);
        const size_t n8 = (size_t)4096 * 1024 / 8;
        for (size_t i = (size_t)me * 512 + tid; i < n8; i += (size_t)nw * 512) { const f32x4 a = *(const f32x4*)(mk + i * 8), b = *(const f32x4*)(mk + i * 8 + 4);
            u32x4 o; o.x = pk2(a.x, a.y); o.y = pk2(a.z, a.w); o.z = pk2(b.x, b.y); o.w = pk2(b.z, b.w); *(u32x4*)(KB + i * 8) = o; }
        LAS float* scr = (LAS float*)(lds + wave * 8448);
        for (int it = me * 8 + wave; it < 64 * 32; it += nw * 8) { const int bh = it >> 5, sub = it & 31, b = bh >> 2, h = bh & 3, kb = sub >> 3, nb = sub & 7;
            transpose_item(mv + (size_t)b * 256 * 1024 + h * 256, 1024, VT + (size_t)bh * 65536, 256, scr, kb * 64, nb * 32, lane); }
        { const int gw2 = me * 8 + wave, NGW2 = nw * 8; int cur = 0;
          transpose_matrix(P.w_out, DM, DM, DM, (bf16_t*)(P.ws + W_OUT), scr, cur, gw2, NGW2, lane);
          transpose_matrix(P.wq, DM, DM, DM, (bf16_t*)(P.ws + W_Q), scr, cur, gw2, NGW2, lane, P.norm_x_w);
          transpose_matrix(P.wo, DM, DM, DM, (bf16_t*)(P.ws + W_O), scr, cur, gw2, NGW2, lane);
          transpose_matrix(P.w1, DFF, DM, DFF, (bf16_t*)(P.ws + W_1), scr, cur, gw2, NGW2, lane, P.norm_ffn_w);
          transpose_matrix(P.w2, DM, DFF, DM, (bf16_t*)(P.ws + W_2), scr, cur, gw2, NGW2, lane);
          bf16_t* VTs = (bf16_t*)(P.ws + W_VTS);
          for (int it = gw2; it < 128 * 32; it += NGW2) { const int bh = it >> 5, sub = it & 31, b = bh >> 2, h = bh & 3, kb = sub >> 3, nb = sub & 7;
              transpose_item(P.cache_v + (size_t)b * 256 * 1024 + h * 256, 1024, VTs + (size_t)bh * 65536, 256, scr, kb * 64, nb * 32, lane); }
          bf16_t* KBs = (bf16_t*)(P.ws + W_KBS); const size_t n8s = (size_t)32 * 256 * 1024 / 8; const float* ck = P.cache_k;
          for (size_t i = (size_t)me * 512 + tid; i < n8s; i += (size_t)nw * 512) { const f32x4 a = *(const f32x4*)(ck + i * 8), b = *(const f32x4*)(ck + i * 8 + 4);
              u32x4 o; o.x = pk2(a.x, a.y); o.y = pk2(a.z, a.w); o.z = pk2(b.x, b.y); o.w = pk2(b.z, b.w); *(u32x4*)(KBs + i * 8) = o; } }
    }
}

DI void phase_attn(const Params& P, LAS unsigned char* lds, int item_lo, int item_hi, int me, int nwg) {
    const int tid = get_tid(), lane = tid & 63, w = tid >> 6, q = lane >> 4, c = lane & 15;
    const bf16_t* QB = (const bf16_t*)(P.ws + W_PROJ);
    const bf16_t* QSb = (const bf16_t*)(P.ws + W_QS);
    bf16_t* ATT = (bf16_t*)(P.ws + W_HCAT);
    const int lr = tid >> 5, lc = (tid & 31) * 8;
    for (int item = item_lo + me; item < item_hi; item += nwg) {
        int b, h, r0, valid; const bf16_t *KB, *VT, *Qrow;
        if (item < 2048) { const int bh = item >> 5, tile = item & 31; b = bh >> 2; h = bh & 3; r0 = b * SEQ + tile * 128; valid = 128;
            KB = (const bf16_t*)(P.ws + W_KBP) + (size_t)b * 256 * 1024; VT = (const bf16_t*)(P.ws + W_VTP) + (size_t)bh * 65536; Qrow = QB + (size_t)r0 * DM; }
        else { const int bh = item - 2048; b = bh >> 2; h = bh & 3; r0 = NP + b * TS; valid = TS;
            KB = (const bf16_t*)(P.ws + W_KBS) + (size_t)b * 256 * 1024; VT = (const bf16_t*)(P.ws + W_VTS) + (size_t)bh * 65536; Qrow = QSb + (size_t)(b * TS) * DM; }
        const int t = w * 16 + c; const bool tv = t < valid;
        bf16x8 qf[8];
#pragma unroll
        for (int k8 = 0; k8 < 8; ++k8) { u32x4 x = (u32x4){0u, 0u, 0u, 0u}; if (tv) x = *(const u32x4*)(Qrow + (size_t)t * DM + h * 256 + k8 * 32 + q * 8); qf[k8] = __builtin_bit_cast(bf16x8, x); }
        u32x4 ra[4], rb[4];
#define AT_LOAD(ra, p) do { if ((p) < 4) { _Pragma("unroll") for (int e = 0; e < 4; ++e) ra[e] = *(const u32x4*)(KB + (size_t)((p) * 64 + lr + 16 * e) * 1024 + h * 256 + lc); } \
                        else { _Pragma("unroll") for (int e = 0; e < 4; ++e) ra[e] = *(const u32x4*)(VT + (size_t)(((p) - 4) * 64 + lr + 16 * e) * 256 + lc); } } while (0)
#define AT_PUT(ra, p) do { LAS bf16_t* dst_ = (LAS bf16_t*)(lds + ((p) & 1) * 33792); _Pragma("unroll") for (int e = 0; e < 4; ++e) *(LAS u32x4*)(dst_ + (lr + 16 * e) * 264 + lc) = ra[e]; } while (0)
        AT_LOAD(ra, 0); AT_LOAD(rb, 1); AT_PUT(ra, 0); AT_LOAD(ra, 2);
        lds_barrier();
        f32x4 sacc[16];
#pragma unroll
        for (int p = 0; p < 4; ++p) {
            if (p & 1) { AT_PUT(ra, p + 1); AT_LOAD(ra, p + 3); } else { AT_PUT(rb, p + 1); AT_LOAD(rb, p + 3); }
            const LAS bf16_t* buf = (const LAS bf16_t*)(lds + (p & 1) * 33792);
#pragma unroll
            for (int nt = 0; nt < 4; ++nt) { const LAS bf16_t* kp = buf + (nt * 16 + c) * 264 + q * 8; f32x4 acc = (f32x4){0.f, 0.f, 0.f, 0.f};
#pragma unroll
                for (int k8 = 0; k8 < 8; ++k8) acc = __builtin_amdgcn_mfma_f32_16x16x32_bf16(*(const LAS bf16x8*)(kp + k8 * 32), qf[k8], acc, 0, 0, 0);
                sacc[p * 4 + nt] = acc; }
            lds_barrier();
        }
        float mx = -INFINITY;
#pragma unroll
        for (int i = 0; i < 16; ++i) mx = fmaxf(mx, fmaxf(fmaxf(sacc[i][0], sacc[i][1]), fmaxf(sacc[i][2], sacc[i][3])));
        mx = fmaxf(mx, __shfl_xor(mx, 16)); mx = fmaxf(mx, __shfl_xor(mx, 32));
        float sum = 0.f;
#pragma unroll
        for (int i = 0; i < 16; ++i)
#pragma unroll
            for (int r = 0; r < 4; ++r) { const float e = __expf((sacc[i][r] - mx) * 0.0625f); sacc[i][r] = e; sum += e; }
        sum += __shfl_xor(sum, 16); sum += __shfl_xor(sum, 32);
        const float inv = 1.f / sum;
        bf16x8 pf[8];
#pragma unroll
        for (int j = 0; j < 8; ++j) { const s16x4 lo = pack4(sacc[2 * j] * inv), hi = pack4(sacc[2 * j + 1] * inv);
            pf[j] = (bf16x8){lo[0], lo[1], lo[2], lo[3], hi[0], hi[1], hi[2], hi[3]}; }
#pragma unroll
        for (int p = 4; p < 8; ++p) {
            if (p + 1 < 8) { if (p & 1) { AT_PUT(ra, p + 1); } else { AT_PUT(rb, p + 1); } }
            if (p + 3 < 8) { if (p & 1) { AT_LOAD(ra, p + 3); } else { AT_LOAD(rb, p + 3); } }
            const LAS bf16_t* buf = (const LAS bf16_t*)(lds + (p & 1) * 33792);
#pragma unroll
            for (int dt = 0; dt < 4; ++dt) { const LAS bf16_t* vp = buf + (dt * 16 + c) * 264 + q * 4; f32x4 acc = (f32x4){0.f, 0.f, 0.f, 0.f};
#pragma unroll
                for (int j = 0; j < 8; ++j) { const s16x4 lo = *(const LAS s16x4*)(vp + 32 * j), hi = *(const LAS s16x4*)(vp + 32 * j + 16);
                    const bf16x8 vf = (bf16x8){lo[0], lo[1], lo[2], lo[3], hi[0], hi[1], hi[2], hi[3]};
                    acc = __builtin_amdgcn_mfma_f32_16x16x32_bf16(vf, pf[j], acc, 0, 0, 0); }
                if (tv) *(s16x4*)(ATT + (size_t)(r0 + t) * DM + h * 256 + (p - 4) * 64 + dt * 16 + q * 4) = pack4(acc); }
            lds_barrier();
        }
#undef AT_LOAD
#undef AT_PUT
    }
}

DI void phase_norm(const Params& P, const float* w) {
    const int tid = get_tid(), lane = tid & 63, gw = blockIdx.x * 8 + (tid >> 6), NGW = gridDim.x * 8;
    bf16_t* XN = (bf16_t*)(P.ws + W_XN);
    f32x4 v[4], nv[4];
    load_row(v, P.out + (size_t)gw * DM, lane);
    for (int r = gw; r < NTOK; r += NGW) { const int rn = r + NGW;
        if (rn < NTOK) load_row(nv, P.out + (size_t)rn * DM, lane);
        norm_row<false>(v, w, XN + (size_t)r * DM, nullptr, nullptr, lane);
#pragma unroll
        for (int j = 0; j < 4; ++j) v[j] = nv[j]; }
}
DI void phase_final(const Params& P, const bf16_t* xb, float* y, int nrows, int gw, int NGW) {
    const int tid = get_tid(), lane = tid & 63;
    u32x4 v[2], nv[2];
    if (gw < nrows) { v[0] = *(const u32x4*)(xb + (size_t)gw * DM + 8 * lane); v[1] = *(const u32x4*)(xb + (size_t)gw * DM + 512 + 8 * lane); }
    f32x4 wv[4];
#pragma unroll
    for (int j = 0; j < 2; ++j) { wv[2 * j] = *(const f32x4*)(P.norm_final_w + 512 * j + 8 * lane); wv[2 * j + 1] = *(const f32x4*)(P.norm_final_w + 512 * j + 8 * lane + 4); }
    for (int r = gw; r < nrows; r += NGW) { const int rn = r + NGW;
        if (rn < nrows) { nv[0] = *(const u32x4*)(xb + (size_t)rn * DM + 8 * lane); nv[1] = *(const u32x4*)(xb + (size_t)rn * DM + 512 + 8 * lane); }
        f32x4 x[4]; float s = 0.f;
#pragma unroll
        for (int j = 0; j < 2; ++j) { x[2 * j] = (f32x4){bflo(v[j].x), bfhi(v[j].x), bflo(v[j].y), bfhi(v[j].y)}; x[2 * j + 1] = (f32x4){bflo(v[j].z), bfhi(v[j].z), bflo(v[j].w), bfhi(v[j].w)}; }
#pragma unroll
        for (int j = 0; j < 4; ++j) s += (x[j].x * x[j].x + x[j].y * x[j].y) + (x[j].z * x[j].z + x[j].w * x[j].w);
        const float rstd = rsqrtf(wave_sum(s) * (1.f / DM) + EPS);
        float* yr = y + (size_t)r * DM;
#pragma unroll
        for (int j = 0; j < 2; ++j) { *(f32x4*)(yr + 512 * j + 8 * lane) = x[2 * j] * rstd * wv[2 * j]; *(f32x4*)(yr + 512 * j + 8 * lane + 4) = x[2 * j + 1] * rstd * wv[2 * j + 1]; }
        v[0] = nv[0]; v[1] = nv[1]; }
}

DI void tree_barrier(unsigned* ctl, unsigned k, unsigned idx = 0xffffffffu, unsigned ngroups = 8u) {
    __builtin_amdgcn_fence(__ATOMIC_RELEASE, "workgroup");
    __builtin_amdgcn_s_barrier();
    if (threadIdx.x == 0) {
        __builtin_amdgcn_fence(__ATOMIC_ACQUIRE, "workgroup");
        __builtin_amdgcn_fence(__ATOMIC_RELEASE, "agent");
        if (idx == 0xffffffffu) idx = blockIdx.x;
        unsigned* grp = ctl + 64 * (idx % ngroups); unsigned* glob = ctl + 64 * 8; unsigned* gen = ctl + 64 * 9;
        const unsigned old = __hip_atomic_fetch_add(grp, 1u, __ATOMIC_RELAXED, __HIP_MEMORY_SCOPE_AGENT);
        if (old == 32u * k - 1u) { const unsigned old2 = __hip_atomic_fetch_add(glob, 1u, __ATOMIC_RELAXED, __HIP_MEMORY_SCOPE_AGENT);
            if (old2 == ngroups * k - 1u) __hip_atomic_store(gen, k, __ATOMIC_RELAXED, __HIP_MEMORY_SCOPE_AGENT); }
        unsigned polls = 0;
        while (__hip_atomic_load(gen, __ATOMIC_RELAXED, __HIP_MEMORY_SCOPE_AGENT) < k) { __builtin_amdgcn_s_sleep(1); if (++polls > 4000000u) break; }
        __builtin_amdgcn_fence(__ATOMIC_ACQUIRE, "agent");
        __builtin_amdgcn_fence(__ATOMIC_RELEASE, "workgroup");
    }
    __builtin_amdgcn_s_barrier();
    __builtin_amdgcn_fence(__ATOMIC_ACQUIRE, "workgroup");
}

DI void rstd_pass(const float* sq, float* rstd, int lo, int hi, int gt, int NT) {
    for (int r = lo + gt; r < hi; r += NT) { const f32x4* sp = (const f32x4*)(sq + (size_t)r * 16); const f32x4 a = sp[0], b = sp[1], c = sp[2], d = sp[3];
        const float tot = (((a.x + a.y) + (a.z + a.w)) + ((b.x + b.y) + (b.z + b.w))) + (((c.x + c.y) + (c.z + c.w)) + ((d.x + d.y) + (d.z + d.w)));
        rstd[r] = rsqrtf(tot * (1.f / DM) + EPS); }
}
DI void sample_pre(const Params& P, LAS unsigned char* lds, unsigned* ctl2, unsigned& k2) {
    const int me = blockIdx.x - 128; unsigned char* ws = P.ws; float* out = P.out;
    { EpiBf16<0, false> e; e.O = (bf16_t*)(ws + W_PROJ) + (size_t)NP * NMAIN; e.ldc = NMAIN; e.rstd = nullptr; run_gemm(lds, (const bf16_t*)(ws + W_XBS), (const bf16_t*)(ws + W_IN), NS, NMAIN, DM, e, 0, 128, me);
      EpiF32 ek; ek.C = out + O_PMK; ek.ldc = DM; run_gemm(lds, (const bf16_t*)(ws + W_MN), (const bf16_t*)(ws + W_K), 4096, DM, DM, ek, 32, 128, me);
      EpiF32 ev; ev.C = out + O_PMV; ev.ldc = DM; run_gemm(lds, (const bf16_t*)(ws + W_MN), (const bf16_t*)(ws + W_V), 4096, DM, DM, ev, 96, 128, me); }
    tree_barrier(ctl2, ++k2, me, 4);
    phase_conv(P, lds, NP, NS, (unsigned)(me * 512 + (int)threadIdx.x), 128u * 512u);
    tree_barrier(ctl2, ++k2, me, 4);
}
DI void sample_chain(const Params& P, LAS unsigned char* lds, unsigned* ctl2, unsigned& k2) {
    const int me = blockIdx.x - 128; unsigned char* ws = P.ws; float* Xs = P.out + (size_t)NP * DM;
    bf16_t* XBS = (bf16_t*)(ws + W_XBS); bf16_t* QS = (bf16_t*)(ws + W_QS); bf16_t* HS = (bf16_t*)(ws + W_HS); const bf16_t* HCs = (const bf16_t*)(ws + W_HCAT) + (size_t)NP * DM;
    float* sq1 = (float*)(ws + W_SQ1) + NP; float* sq2 = (float*)(ws + W_SQ2) + NP;
    tree_barrier(ctl2, ++k2, me, 4);
    { EpiResB<true> e; e.resF = P.x_sample; e.resB = nullptr; e.XB = XBS; e.sq = sq1; run_gemm(lds, HCs, (const bf16_t*)(ws + W_OUT), NS, DM, DM, e, 0, 128, me); }
    tree_barrier(ctl2, ++k2, me, 4);
    { EpiBf16<0, true> e; e.O = QS; e.ldc = DM; e.rstd = sq1; run_gemm(lds, XBS, (const bf16_t*)(ws + W_Q), NS, DM, DM, e, 0, 128, me); }
    tree_barrier(ctl2, ++k2, me, 4);
    phase_attn(P, lds, 2048, 2048 + 128, me, 128);
    tree_barrier(ctl2, ++k2, me, 4);
    { EpiResB<false> e; e.resF = nullptr; e.resB = XBS; e.XB = XBS; e.sq = sq2; run_gemm(lds, HCs, (const bf16_t*)(ws + W_O), NS, DM, DM, e, 0, 128, me); }
    tree_barrier(ctl2, ++k2, me, 4);
    { EpiBf16<1, true> e; e.O = HS; e.ldc = DFF; e.rstd = sq2; run_gemm(lds, XBS, (const bf16_t*)(ws + W_1), NS, DFF, DM, e, 0, 128, me); }
    tree_barrier(ctl2, ++k2, me, 4);
    { EpiResB<false> e; e.resF = nullptr; e.resB = XBS; e.XB = XBS; e.sq = nullptr; run_gemm(lds, HS, (const bf16_t*)(ws + W_2), NS, DM, DFF, e, 0, 128, me); }
    tree_barrier(ctl2, ++k2, me, 4);
    phase_final(P, XBS, Xs, NS, me * 8 + (int)(threadIdx.x >> 6), 1024);
}

__global__ __launch_bounds__(512, 2) void mega_fwd(Params P) {
    extern __shared__ __attribute__((aligned(16))) unsigned char shm[];
    LAS unsigned char* lds = (LAS unsigned char*)shm;
    cg::grid_group grid = cg::this_grid();
    unsigned char* ws = P.ws; float* out = P.out; unsigned* ctl = (unsigned*)(ws + W_CTL); unsigned bk = 0;
    phase0(P, lds);
#ifdef PROBE_P0X2
    grid.sync();
    phase0(P, lds);
#endif
    if (blockIdx.x == 0 && threadIdx.x == 0) { Params* t = (Params*)(ws + W_TAB); t->x_prompt = P.x_prompt; t->x_sample = P.x_sample; t->st_C = P.st_C; t->st_n = P.st_n; t->st_m = P.st_m; t->st_S = P.st_S; t->st_conv = P.st_conv; t->cache_k = P.cache_k; t->cache_v = P.cache_v; t->mem_prompt = P.mem_prompt; t->norm_mix_w = P.norm_mix_w; t->w_in = P.w_in; t->ig_b = P.ig_b; t->fg_b = P.fg_b; t->mlstm_norm_w = P.mlstm_norm_w; t->conv_w = P.conv_w; t->A_log = P.A_log; t->dt_bias = P.dt_bias; t->gdn_norm_w = P.gdn_norm_w; t->w_out = P.w_out; t->norm_x_w = P.norm_x_w; t->norm_mem_w = P.norm_mem_w; t->wq = P.wq; t->wk = P.wk; t->wv = P.wv; t->wo = P.wo; t->norm_ffn_w = P.norm_ffn_w; t->w1 = P.w1; t->w2 = P.w2; t->norm_final_w = P.norm_final_w; t->out = P.out; t->ws = P.ws; }
    if (blockIdx.x == 0) for (int i = threadIdx.x; i < 2048; i += 512) ctl[i] = 0u;
    grid.sync();
    const Params& T = *(const Params*)(ws + W_TAB);
    { EpiBf16<0, false> e; e.O = (bf16_t*)(ws + W_PROJ); e.ldc = NMAIN; e.rstd = nullptr;
      run_gemm(lds, (const bf16_t*)(ws + W_XN), (const bf16_t*)(ws + W_IN), NP, NMAIN, DM, e, 0); }
    tree_barrier(ctl, ++bk);
    phase_conv(T, lds, 0, NP, blockIdx.x * 512u + threadIdx.x, gridDim.x * 512u);
#ifdef PROBE_CONVX2
    tree_barrier(ctl, ++bk);
    phase_conv(T, lds);
#endif
    tree_barrier(ctl, ++bk);
    unsigned k2 = 0;
    if (blockIdx.x >= 128) sample_pre(T, lds, ctl + 1024, k2);
    phase2(T, lds, -1);
    if (blockIdx.x >= 128) sample_chain(T, lds, ctl + 1024, k2);
    tree_barrier(ctl, ++bk);
    { EpiResB<true> e; e.resF = T.x_prompt; e.resB = nullptr; e.XB = (bf16_t*)(ws + W_XN); e.sq = (float*)(ws + W_SQ1); run_gemm(lds, (const bf16_t*)(ws + W_HCAT), (const bf16_t*)(ws + W_OUT), NP, DM, DM, e, 0); }
    tree_barrier(ctl, ++bk);
    { EpiBf16<0, true> e; e.O = (bf16_t*)(ws + W_PROJ); e.ldc = DM; e.rstd = (const float*)(ws + W_SQ1); run_gemm(lds, (const bf16_t*)(ws + W_XN), (const bf16_t*)(ws + W_Q), NP, DM, DM, e, 0); }
    tree_barrier(ctl, ++bk);
    phase_attn(T, lds, 0, 2048, (int)blockIdx.x, (int)gridDim.x);
    tree_barrier(ctl, ++bk);
    { EpiResB<false> e; e.resF = nullptr; e.resB = (const bf16_t*)(ws + W_XN); e.XB = (bf16_t*)(ws + W_XN); e.sq = (float*)(ws + W_SQ2); run_gemm(lds, (const bf16_t*)(ws + W_HCAT), (const bf16_t*)(ws + W_O), NP, DM, DM, e, 0); }
    tree_barrier(ctl, ++bk);
    { EpiBf16<1, true> e; e.O = (bf16_t*)(ws + W_PROJ); e.ldc = DFF; e.rstd = (const float*)(ws + W_SQ2); run_gemm(lds, (const bf16_t*)(ws + W_XN), (const bf16_t*)(ws + W_1), NP, DFF, DM, e, 0); }
    tree_barrier(ctl, ++bk);
    { EpiResB<false> e; e.resF = nullptr; e.resB = (const bf16_t*)(ws + W_XN); e.XB = (bf16_t*)(ws + W_XN); e.sq = nullptr; run_gemm(lds, (const bf16_t*)(ws + W_PROJ), (const bf16_t*)(ws + W_2), NP, DM, DFF, e, 0); }
    tree_barrier(ctl, ++bk);
    phase_final(T, (const bf16_t*)(ws + W_XN), out, NP, (int)(blockIdx.x * 8 + (threadIdx.x >> 6)), (int)gridDim.x * 8);
#ifdef PROBE_SYNCX
    for (int i = 0; i < PROBE_SYNCX; ++i) tree_barrier(ctl, ++bk);
#endif
}

extern "C" void kernel_launch(void* const* d_in, const int* in_sizes, int n_in, void* d_out, int out_size, void* d_ws, size_t ws_size, hipStream_t stream) {
    static int grid_blocks = 0;
    if (grid_blocks == 0) {
        if (n_in != 30 || (size_t)out_size != O_END || ws_size < W_END) { fprintf(stderr, "kernel_launch: unexpected shapes: n_in %d out %d ws %zu (need %zu)\n", n_in, out_size, ws_size, (size_t)W_END); grid_blocks = -1; return; }
        int dev = 0, cus = 0, per_cu = 0;
        hipGetDevice(&dev);
        hipDeviceGetAttribute(&cus, hipDeviceAttributeMultiprocessorCount, dev);
        if (hipFuncSetAttribute((const void*)mega_fwd, hipFuncAttributeMaxDynamicSharedMemorySize, LDS_BYTES) != hipSuccess) { fprintf(stderr, "kernel_launch: hipFuncSetAttribute failed\n"); grid_blocks = -1; return; }
        if (hipOccupancyMaxActiveBlocksPerMultiprocessor(&per_cu, (const void*)mega_fwd, 512, LDS_BYTES) != hipSuccess || per_cu < 1) { fprintf(stderr, "kernel_launch: occupancy query gave %d\n", per_cu); (void)hipGetLastError(); grid_blocks = -1; return; }
        grid_blocks = cus * per_cu;
        if (grid_blocks != 256) { fprintf(stderr, "kernel_launch: expected 256 resident workgroups, got %d\n", grid_blocks); grid_blocks = -1; return; }
    }
    if (grid_blocks < 0) return;
    Params p{};
    const float* const* in = (const float* const*)d_in;
    p.x_prompt = in[0]; p.x_sample = in[1]; p.st_C = in[2]; p.st_n = in[3]; p.st_m = in[4]; p.st_S = in[5]; p.st_conv = in[6]; p.cache_k = in[7]; p.cache_v = in[8]; p.mem_prompt = in[9];
    p.norm_mix_w = in[10]; p.w_in = in[11]; p.ig_b = in[12]; p.fg_b = in[13]; p.mlstm_norm_w = in[14]; p.conv_w = in[15]; p.A_log = in[16]; p.dt_bias = in[17]; p.gdn_norm_w = in[18]; p.w_out = in[19];
    p.norm_x_w = in[20]; p.norm_mem_w = in[21]; p.wq = in[22]; p.wk = in[23]; p.wv = in[24]; p.wo = in[25]; p.norm_ffn_w = in[26]; p.w1 = in[27]; p.w2 = in[28]; p.norm_final_w = in[29];
    p.out = (float*)d_out; p.ws = (unsigned char*)d_ws;
    void* args[] = {&p};
    hipError_t e = hipLaunchCooperativeKernel((const void*)mega_fwd, dim3(grid_blocks), dim3(512), args, LDS_BYTES, stream);
    if (e != hipSuccess) fprintf(stderr, "cooperative launch failed: %s (grid %d)\n", hipGetErrorString(e), grid_blocks);
}
```
